# Optimizing an MI355X kernel written in HIP

```python
import jax, jax.numpy as jnp
from jax import lax
import numpy as np

D_MODEL = 1024
BATCH = 4
SEQ = 4096
DEPTH = 2

CHUNK = 64
EPS = 1e-6
D_CONV = D_MODEL // 2
N_CONV_GROUPS = 4
CONV_WIDTH = 31
D_POOL = D_MODEL // 2
POOL_WINDOWS = (2, 4, 8, 16)
N_POOL_GROUPS = len(POOL_WINDOWS)
POOL_GROUP = D_POOL // N_POOL_GROUPS
HG_HEADS = 8
HG_DK = D_MODEL // HG_HEADS
HG_DV = HG_DK
D_HG = HG_HEADS * HG_DK
D_FF = -(-8 * D_MODEL // (3 * 256)) * 256
N_EVEN = (DEPTH + 1) // 2
N_ODD = DEPTH // 2

kernel_name = "hybrid_conformer_pool_hgrn2_trunk"


def rmsnorm(x, g):
    xf = x.astype(jnp.float32)
    y = xf * lax.rsqrt(jnp.mean(xf * xf, axis=-1, keepdims=True) + EPS)
    return (y * g.astype(jnp.float32)).astype(x.dtype)


def layernorm(x, g, b):
    xf = x.astype(jnp.float32)
    mu = jnp.mean(xf, axis=-1, keepdims=True)
    var = jnp.mean(jnp.square(xf - mu), axis=-1, keepdims=True)
    y = (xf - mu) * lax.rsqrt(var + EPS)
    return (y * g.astype(jnp.float32) + b.astype(jnp.float32)).astype(x.dtype)


def swiglu_ffn(h, w1, w3, w2):
    return (jax.nn.silu(h @ w1) * (h @ w3)) @ w2


def conv_pool_mixer(h, w_in, dw_w, dw_b, ln_g, ln_b, pool_w, pool_scale, w_out):
    B, T, _ = h.shape
    z = h @ w_in
    a_val = z[..., :D_CONV]
    a_gate = z[..., D_CONV:2 * D_CONV]
    u = z[..., 2 * D_CONV:]

    a = a_val * jax.nn.sigmoid(a_gate)
    a = lax.conv_general_dilated(
        a, dw_w[:, None, :].astype(a.dtype), window_strides=(1,),
        padding=[(CONV_WIDTH - 1, 0)],
        dimension_numbers=('NWC', 'WIO', 'NWC'),
        feature_group_count=D_CONV) + dw_b
    a = jax.nn.silu(layernorm(a, ln_g, ln_b))

    ug = u.reshape(B, T, N_POOL_GROUPS, POOL_GROUP)
    cs = jnp.cumsum(ug.astype(jnp.float32), axis=1)
    cs = jnp.pad(cs, ((0, 0), (1, 0), (0, 0), (0, 0)))
    t = jnp.arange(T)
    means = []
    for g, w in enumerate(POOL_WINDOWS):
        lo = jnp.maximum(t + 1 - w, 0)
        s = cs[:, 1:, g] - cs[:, lo, g]
        cnt = jnp.minimum(t + 1, w).astype(jnp.float32)[:, None]
        means.append(s / cnt)
    pooled = jnp.stack(means, axis=2)
    d = (pooled - ug.astype(jnp.float32)).astype(u.dtype)
    p = jnp.einsum('btgc,gcd->btgd', d, pool_w).reshape(B, T, D_POOL) * pool_scale

    return jnp.concatenate([a, p], axis=-1) @ w_out


def hgrn2_mixer(h, w_in, lb, gn_g, w_out):
    B, T, _ = h.shape
    NC = T // CHUNK
    z = h @ w_in
    q, f_raw, i, g = jnp.split(z, 4, axis=-1)
    f = lb + (1.0 - lb) * jax.nn.sigmoid(f_raw.astype(jnp.float32))
    log_f = jnp.log(f)
    k = 1.0 - f

    def to_chunks(a, dh):
        a = a.astype(jnp.float32).reshape(B, NC, CHUNK, HG_HEADS, dh)
        return a.transpose(1, 0, 3, 2, 4)

    qc = to_chunks(q, HG_DK)
    kc = to_chunks(k, HG_DK)
    vc = to_chunks(i, HG_DV)
    bc = jnp.cumsum(to_chunks(log_f, HG_DK), axis=3)
    tril = jnp.tril(jnp.ones((CHUNK, CHUNK), dtype=bool))

    def step(S, inp):
        qt, kt, vt, bt = inp
        diff = bt[:, :, :, None, :] - bt[:, :, None, :, :]
        decay = jnp.exp(jnp.where(tril[:, :, None], diff, -jnp.inf))
        scores = jnp.einsum('bhtk,bhsk,bhtsk->bhts', qt, kt, decay)
        o = (jnp.einsum('bhts,bhsv->bhtv', scores, vt)
             + jnp.einsum('bhtk,bhkv->bhtv', qt * jnp.exp(bt), S))
        b_last = bt[:, :, -1:, :]
        S = (jnp.exp(b_last[:, :, 0, :])[..., None] * S
             + jnp.einsum('bhsk,bhsv->bhkv', kt * jnp.exp(b_last - bt), vt))
        return S, o

    S0 = jnp.zeros((B, HG_HEADS, HG_DK, HG_DV), jnp.float32)
    _, o = lax.scan(step, S0, (qc, kc, vc, bc))
    o = o.transpose(1, 0, 3, 2, 4).reshape(B, T, HG_HEADS, HG_DV)
    o = o * lax.rsqrt(jnp.mean(o * o, axis=-1, keepdims=True) + EPS)
    o = o * gn_g.astype(jnp.float32).reshape(HG_HEADS, HG_DV)
    o = o.reshape(B, T, D_HG).astype(h.dtype) * jax.nn.silu(g)
    return o @ w_out


def setup_inputs(seed: int = 0) -> dict:
    key = jax.random.key(seed)
    ks = jax.random.split(key, 20)
    nrm = lambda k, shape, s: jax.random.normal(k, shape, jnp.float32) * s
    gain = lambda k, shape: 1.0 + 0.05 * jax.random.normal(k, shape, jnp.float32)
    d_in0 = 2 * D_CONV + D_POOL
    return {
        "x": jax.random.normal(ks[0], (BATCH, SEQ, D_MODEL), jnp.float32),
        "norm_mix_g": gain(ks[1], (DEPTH, D_MODEL)),
        "norm_ffn_g": gain(ks[2], (DEPTH, D_MODEL)),
        "final_g": gain(ks[3], (D_MODEL,)),
        "cp_w_in": nrm(ks[4], (N_EVEN, D_MODEL, d_in0), D_MODEL ** -0.5),
        "cp_dw_w": nrm(ks[5], (N_EVEN, CONV_WIDTH, D_CONV), CONV_WIDTH ** -0.5),
        "cp_dw_b": nrm(ks[6], (N_EVEN, D_CONV), 0.01),
        "cp_ln_g": gain(ks[7], (N_EVEN, D_CONV)),
        "cp_ln_b": nrm(ks[8], (N_EVEN, D_CONV), 0.01),
        "cp_pool_w": nrm(ks[9], (N_EVEN, N_POOL_GROUPS, POOL_GROUP, POOL_GROUP), POOL_GROUP ** -0.5),
        "cp_pool_scale": gain(ks[10], (N_EVEN, D_POOL)),
        "cp_w_out": nrm(ks[11], (N_EVEN, D_CONV + D_POOL, D_MODEL), (D_CONV + D_POOL) ** -0.5),
        "hg_w_in": nrm(ks[12], (N_ODD, D_MODEL, 4 * D_HG), D_MODEL ** -0.5),
        "hg_lb_logits": nrm(ks[13], (DEPTH, D_HG), 0.1),
        "hg_gn_g": gain(ks[14], (N_ODD, D_HG)),
        "hg_w_out": nrm(ks[15], (N_ODD, D_HG, D_MODEL), D_HG ** -0.5),
        "ffn_w1": nrm(ks[16], (DEPTH, D_MODEL, D_FF), D_MODEL ** -0.5),
        "ffn_w3": nrm(ks[17], (DEPTH, D_MODEL, D_FF), D_MODEL ** -0.5),
        "ffn_w2": nrm(ks[18], (DEPTH, D_FF, D_MODEL), D_FF ** -0.5),
    }


def reference(x, norm_mix_g, norm_ffn_g, final_g, cp_w_in, cp_dw_w, cp_dw_b,
              cp_ln_g, cp_ln_b, cp_pool_w, cp_pool_scale, cp_w_out, hg_w_in,
              hg_lb_logits, hg_gn_g, hg_w_out, ffn_w1, ffn_w3, ffn_w2):
    p = jax.nn.softmax(hg_lb_logits.astype(jnp.float32), axis=0)
    lower_bounds = jnp.cumsum(p, axis=0) - p[0:1]
    h = x
    for layer in range(DEPTH):
        hn = rmsnorm(h, norm_mix_g[layer])
        j = layer // 2
        if layer % 2 == 0:
            mix = conv_pool_mixer(hn, cp_w_in[j], cp_dw_w[j], cp_dw_b[j], cp_ln_g[j],
                                  cp_ln_b[j], cp_pool_w[j], cp_pool_scale[j], cp_w_out[j])
        else:
            mix = hgrn2_mixer(hn, hg_w_in[j], lower_bounds[layer], hg_gn_g[j], hg_w_out[j])
        h = h + mix
        h = h + swiglu_ffn(rmsnorm(h, norm_ffn_g[layer]), ffn_w1[layer], ffn_w3[layer], ffn_w2[layer])
    return rmsnorm(h, final_g)
```

```cpp
#include <hip/hip_runtime.h>
#include <hip/hip_cooperative_groups.h>
#include <cstdio>
#include <cstdint>
namespace cg = cooperative_groups;
namespace pg8 {
#define PG8_LAS __attribute__((address_space(3)))
typedef unsigned short bf16_t;
typedef short bf16x8 __attribute__((ext_vector_type(8)));
typedef float f32x4 __attribute__((ext_vector_type(4)));
typedef unsigned u32x4 __attribute__((ext_vector_type(4)));
constexpr int BM = 256, BK = 64, HALF = 128, HTB = HALF * BK * 2  , STAGE_BYTES = 8 * HTB, NXCD = 8, WGM = 8;

__host__ __device__ __forceinline__ int lds_byte(int r, int c) { const int st = (r >> 4) * 2 + (c >> 5), rr = r & 15, cc = c & 31, ob = rr * 64 + cc * 2; return st * 1024 + (ob ^ (((ob >> 9) & 1) << 5)); }
__host__ __device__ __forceinline__ void stage_rc(int b, int& R, int& C) { const int st = b / 1024, sb = b % 1024, swz = sb ^ (((sb >> 9) & 1) << 5); R = (st >> 1) * 16 + swz / 64; C = (st & 1) * 32 + (swz % 64) / 2; }
__host__ __device__ __forceinline__ int perm32(int rho) { const int n = rho >> 4, i = rho & 15; return 8 * (i >> 2) + 4 * n + (i & 3); }

struct Unit { int pm, pn; };
struct Gemm { const bf16_t* A; const bf16_t* Bt; int M, N, K; };

struct StaticOrder {
    int nM, nN, nwg, G, c;
    __host__ __device__ void init(int M, int N, int G_, int c_) { nM = M / BM; nN = N / BM; nwg = nM * nN; G = G_; c = c_; }
    __host__ __device__ bool next(int i, Unit& u) const {
        const long L = (long)i * G + c; if (L >= nwg) return false;
        int wgid = (int)L; { const int q = nwg / NXCD, r = nwg % NXCD, xcd = wgid % NXCD, off = wgid / NXCD; wgid = (xcd < r ? xcd * (q + 1) : r * (q + 1) + (xcd - r) * q) + off; }
        const int nig = WGM * nN, gid = wgid / nig, fm = gid * WGM, gsz = (nM - fm) < WGM ? (nM - fm) : WGM;
        u.pm = fm + ((wgid % nig) % gsz); u.pn = (wgid % nig) / gsz; return true;
    }
    __device__ __forceinline__ void a_ready(const Unit&) const {}
    __device__ __forceinline__ void done(const Unit&) const {}
};

__device__ __forceinline__ unsigned cvt_pk_bf16(float lo, float hi) { unsigned r; asm volatile("v_cvt_pk_bf16_f32 %0, %1, %2" : "=v"(r) : "v"(lo), "v"(hi)); return r; }
template <class Epi, class Sched, bool ALIGN_EPI = false, bool SP2 = false>
__device__ __forceinline__ void gemm_phase(PG8_LAS unsigned char* lds, const Gemm g, const Sched& S, const Epi& E) {
    const int tid = threadIdx.x, wid = __builtin_amdgcn_readfirstlane(tid >> 6), lane = tid & 63, wr = wid >> 2, wc = wid & 3, fr = lane & 15, fq = lane >> 4;
    const int K = g.K, nt = K / BK;
    unsigned voffA[2], voffB[2];
#pragma unroll
    for (int i = 0; i < 2; ++i) { int R, C; stage_rc(tid * 16 + i * 8192, R, C); const int Rb = Epi::PERM ? ((R & ~31) + perm32(R & 31)) : R;
        voffA[i] = (unsigned)(R * K + C) * 2u; voffB[i] = (unsigned)(Rb * K + C) * 2u; }
    const size_t kstep = (size_t)(BK * 2);
    const size_t hstep = (size_t)HALF * K * 2;
    const size_t tstep = 2 * hstep;
    const unsigned ldsw = (unsigned)wid * 1024u;
    const int aoff = lds_byte(wr * 64 + fr, fq * 8), boff = lds_byte(wc * 32 + fr, fq * 8);
#define PG8_SA(b, h) (((b) * 2 + (h)) * HTB)
#define PG8_SB(b, h) ((4 + (b) * 2 + (h)) * HTB)
#define PG8_STAGE(bufoff, gbase, voff) do { _Pragma("unroll") for (int _i = 0; _i < 2; ++_i) \
        __builtin_amdgcn_global_load_lds((const unsigned*)((const char*)(gbase) + (voff)[_i]), (PG8_LAS unsigned*)(lds + (bufoff) + ldsw + _i * 8192), 16, 0, 0); } while (0)
#define PG8_LDA(dst, b, h) do { _Pragma("unroll") for (int m = 0; m < 4; ++m) _Pragma("unroll") for (int k = 0; k < 2; ++k) dst[m][k] = *(const PG8_LAS bf16x8*)(lds + PG8_SA(b, h) + aoff + m * 2048 + k * 1024); } while (0)
#define PG8_LDB(dst, b, h) do { _Pragma("unroll") for (int n = 0; n < 2; ++n) _Pragma("unroll") for (int k = 0; k < 2; ++k) dst[n][k] = *(const PG8_LAS bf16x8*)(lds + PG8_SB(b, h) + boff + n * 2048 + k * 1024); } while (0)
#define PG8_MMA(ai, bj, At, Bt) do { __builtin_amdgcn_s_setprio(1); _Pragma("unroll") for (int m = 0; m < 4; ++m) _Pragma("unroll") for (int n = 0; n < 2; ++n) _Pragma("unroll") for (int k = 0; k < 2; ++k) \
        acc[ai][bj][m][n] = __builtin_amdgcn_mfma_f32_16x16x32_bf16(Bt[n][k], At[m][k], acc[ai][bj][m][n], 0, 0, 0); __builtin_amdgcn_s_setprio(0); } while (0)
#define PG8_WAIT_V(n) asm volatile("s_waitcnt vmcnt(" #n ")" ::: "memory")
#define PG8_WAIT_L(n) asm volatile("s_waitcnt lgkmcnt(" #n ")" ::: "memory")
#define PG8_BAR __builtin_amdgcn_s_barrier()
#define PG8_SCHED __builtin_amdgcn_sched_barrier(0)
    Unit cur, nxt; int ui = 0;
    if (!S.next(0, cur)) return;
    f32x4 acc[2][2][4][2];
#pragma unroll
    for (int a = 0; a < 2; ++a)
#pragma unroll
        for (int b = 0; b < 2; ++b)
#pragma unroll
            for (int m = 0; m < 4; ++m)
#pragma unroll
                for (int n = 0; n < 2; ++n) acc[a][b][m][n] = (f32x4){0.f, 0.f, 0.f, 0.f};
    bf16x8 At[4][2], B0[2][2], B1[2][2];
    const char* cA = (const char*)g.A + (size_t)cur.pm * tstep; const char* cB = (const char*)g.Bt + (size_t)cur.pn * tstep;
    S.a_ready(cur);
    if constexpr (SP2) {
        PG8_STAGE(PG8_SB(0, 0), cB, voffB); PG8_STAGE(PG8_SB(0, 1), cB + hstep, voffB); PG8_STAGE(PG8_SA(0, 0), cA, voffA); PG8_STAGE(PG8_SA(0, 1), cA + hstep, voffA);
        if (wr == 1) PG8_BAR;
        PG8_WAIT_V(2); PG8_BAR;
        PG8_STAGE(PG8_SB(1, 0), cB + kstep, voffB); PG8_STAGE(PG8_SA(1, 0), cA + kstep, voffA); PG8_STAGE(PG8_SB(1, 1), cB + hstep + kstep, voffB);
        PG8_WAIT_V(6); PG8_BAR;
    } else {
        PG8_STAGE(PG8_SB(0, 0), cB, voffB); PG8_STAGE(PG8_SA(0, 0), cA, voffA); PG8_STAGE(PG8_SB(0, 1), cB + hstep, voffB); PG8_STAGE(PG8_SA(0, 1), cA + hstep, voffA);
        if (wr == 1) PG8_BAR;
        PG8_WAIT_V(4); PG8_BAR;
        PG8_STAGE(PG8_SB(1, 0), cB + kstep, voffB); PG8_STAGE(PG8_SA(1, 0), cA + kstep, voffA); PG8_STAGE(PG8_SB(1, 1), cB + hstep + kstep, voffB);
        PG8_WAIT_V(6); PG8_BAR;
    }
    for (;;) {
        const bool has_next = S.next(ui + 1, nxt);
        const char* nA = has_next ? (const char*)g.A + (size_t)nxt.pm * tstep : cA; const char* nB = has_next ? (const char*)g.Bt + (size_t)nxt.pn * tstep : cB;
        for (int t = 0; t < nt; t += 2) {
            const bool last = (t == nt - 2);
            const char* a1 = cA + (size_t)(t + 1) * kstep;
            const char* a2 = last ? nA : cA + (size_t)(t + 2) * kstep; const char* b2 = last ? nB : cB + (size_t)(t + 2) * kstep;
            const char* a3 = a2 + kstep; const char* b3 = b2 + kstep;
            if (last && has_next) S.a_ready(nxt);
            if constexpr (SP2) {
            PG8_LDB(B0, 0, 0); PG8_LDB(B1, 0, 1); PG8_SCHED; PG8_LDA(At, 0, 0); PG8_STAGE(PG8_SA(1, 1), a1 + hstep, voffA);
            PG8_WAIT_V(8); PG8_WAIT_L(0); PG8_BAR; PG8_MMA(0, 0, At, B0); PG8_MMA(0, 1, At, B1); PG8_BAR; PG8_SCHED;
            PG8_LDA(At, 0, 1); PG8_STAGE(PG8_SB(0, 0), b2, voffB); PG8_STAGE(PG8_SB(0, 1), b2 + hstep, voffB); PG8_STAGE(PG8_SA(0, 0), a2, voffA);
            PG8_WAIT_V(8); PG8_WAIT_L(0); PG8_BAR; PG8_MMA(1, 0, At, B0); PG8_MMA(1, 1, At, B1); PG8_BAR; PG8_SCHED;
            PG8_LDB(B0, 1, 0); PG8_LDB(B1, 1, 1); PG8_SCHED; PG8_LDA(At, 1, 0); PG8_STAGE(PG8_SA(0, 1), a2 + hstep, voffA);
            PG8_WAIT_V(8); PG8_WAIT_L(0); PG8_BAR; PG8_MMA(0, 0, At, B0); PG8_MMA(0, 1, At, B1); PG8_BAR; PG8_SCHED;
            PG8_LDA(At, 1, 1); PG8_STAGE(PG8_SB(1, 0), b3, voffB); PG8_STAGE(PG8_SB(1, 1), b3 + hstep, voffB); PG8_STAGE(PG8_SA(1, 0), a3, voffA);
            PG8_WAIT_V(8); PG8_WAIT_L(0); PG8_BAR; PG8_MMA(1, 0, At, B0); PG8_MMA(1, 1, At, B1); PG8_BAR; PG8_SCHED;
            } else {
            PG8_LDB(B0, 0, 0); PG8_SCHED; PG8_LDA(At, 0, 0); PG8_STAGE(PG8_SA(1, 1), a1 + hstep, voffA);
            PG8_WAIT_L(8); PG8_BAR; PG8_WAIT_L(0); PG8_MMA(0, 0, At, B0); PG8_BAR; PG8_SCHED;
            PG8_LDB(B1, 0, 1); PG8_STAGE(PG8_SB(0, 0), b2, voffB);
            PG8_BAR; PG8_WAIT_L(0); PG8_MMA(0, 1, At, B1); PG8_BAR;
            PG8_LDA(At, 0, 1); PG8_STAGE(PG8_SA(0, 0), a2, voffA);
            PG8_BAR; PG8_WAIT_L(0); PG8_MMA(1, 0, At, B0); PG8_BAR; PG8_SCHED;
            PG8_STAGE(PG8_SB(0, 1), b2 + hstep, voffB);
            PG8_WAIT_V(6); PG8_BAR; PG8_MMA(1, 1, At, B1); PG8_BAR;
            PG8_LDB(B0, 1, 0); PG8_SCHED; PG8_LDA(At, 1, 0); PG8_STAGE(PG8_SA(0, 1), a2 + hstep, voffA);
            PG8_WAIT_L(8); PG8_BAR; PG8_WAIT_L(0); PG8_MMA(0, 0, At, B0); PG8_BAR; PG8_SCHED;
            PG8_LDB(B1, 1, 1); PG8_STAGE(PG8_SB(1, 0), b3, voffB);
            PG8_BAR; PG8_WAIT_L(0); PG8_MMA(0, 1, At, B1); PG8_BAR;
            PG8_LDA(At, 1, 1); PG8_STAGE(PG8_SA(1, 0), a3, voffA);
            PG8_BAR; PG8_WAIT_L(0); PG8_MMA(1, 0, At, B0); PG8_BAR; PG8_SCHED;
            PG8_STAGE(PG8_SB(1, 1), b3 + hstep, voffB);
            PG8_WAIT_V(6); PG8_BAR; PG8_MMA(1, 1, At, B1); PG8_BAR;
            }
        }
        if constexpr (ALIGN_EPI) { if (wr == 0) PG8_BAR; }
        if constexpr (!Epi::AFTER_DRAIN) { E(acc, cur, wr, wc, fr, fq); S.done(cur); }
        if (!has_next) break;
#pragma unroll
        for (int a = 0; a < 2; ++a)
#pragma unroll
            for (int b = 0; b < 2; ++b)
#pragma unroll
                for (int m = 0; m < 4; ++m)
#pragma unroll
                    for (int n = 0; n < 2; ++n) acc[a][b][m][n] = (f32x4){0.f, 0.f, 0.f, 0.f};
        cur = nxt; cA = nA; cB = nB; ++ui;
        if constexpr (ALIGN_EPI) { if (wr == 1) PG8_BAR; }
    }
    PG8_WAIT_V(0);
    if constexpr (!ALIGN_EPI) { if (wr == 0) PG8_BAR; }
    PG8_BAR;
    if constexpr (Epi::AFTER_DRAIN) { E.fused(acc, cur, wr, wc, fr, fq, lds, wid, lane); S.done(cur); }
#undef PG8_SA
#undef PG8_SB
#undef PG8_STAGE
#undef PG8_LDA
#undef PG8_LDB
#undef PG8_MMA
#undef PG8_WAIT_V
#undef PG8_WAIT_L
#undef PG8_BAR
#undef PG8_SCHED
}
}

#define LAS __attribute__((address_space(3)))
typedef unsigned short bf16;
typedef unsigned v4u __attribute__((ext_vector_type(4)));
typedef unsigned v2u __attribute__((ext_vector_type(2)));
typedef float f32x4 __attribute__((ext_vector_type(4)));
typedef short bf16x8 __attribute__((ext_vector_type(8)));
constexpr int M = 16384, D = 1024, T = 4096, FF = 2816, NUP = 2 * FF, NIN0 = 1536, NHG = 4096;
constexpr float EPS = 1e-6f;
constexpr int NWAVES = 8, NTHR = 512;
constexpr int LDS_BYTES = 147456;
constexpr size_t MiB = 1u << 20;
constexpr size_t WS_WIN0 = 0, WS_WOUT0 = 3 * MiB, WS_PW = 5 * MiB, WS_UP0 = 5 * MiB + 512 * 1024, WS_DN0 = 16 * MiB + 512 * 1024, WS_HGIN = 22 * MiB;
constexpr size_t WS_HB = 30 * MiB;
constexpr size_t WS_Z = 64 * MiB;
constexpr size_t WS_AG = WS_Z, WS_UU = WS_Z + 16 * MiB, WS_CAT = WS_Z + 32 * MiB, WS_DD = WS_Z + 64 * MiB;
constexpr size_t WS_HID = WS_Z;
constexpr size_t WS_Q = WS_Z, WS_F = WS_Z + 32 * MiB, WS_V = WS_Z + 96 * MiB, WS_G = WS_Z + 128 * MiB;
constexpr size_t WS_U = 0;
constexpr size_t WS_HGOUT = 224 * MiB, WS_UP1 = 226 * MiB, WS_DN1 = 237 * MiB;
constexpr size_t WS_SS = 243 * MiB;
constexpr size_t WS_DEC = 244 * MiB;
constexpr size_t WS_CTL = 245 * MiB, CTL_ZERO_BYTES = 64 * 1024;
constexpr size_t WS_END = 246 * MiB;
constexpr int LDSCTL_OFF = 131072, MISC_OFF = LDSCTL_OFF + 320;

__device__ __forceinline__ float wave_sum(float v) {
#pragma unroll
    for (int o = 1; o < 64; o <<= 1) v += __shfl_xor(v, o);
    return v;
}
typedef float f32x2_t __attribute__((ext_vector_type(2)));
typedef __bf16 bf16x2_t __attribute__((ext_vector_type(2)));
__device__ __forceinline__ unsigned pk2(float lo, float hi) { f32x2_t v = {lo, hi}; bf16x2_t b = __builtin_convertvector(v, bf16x2_t); return __builtin_bit_cast(unsigned, b); }
__device__ __forceinline__ float bflo(unsigned w) { return __uint_as_float(w << 16); }
__device__ __forceinline__ float bfhi(unsigned w) { return __uint_as_float(w & 0xffff0000u); }
__device__ __forceinline__ float sigmoidf_(float x) { return __builtin_amdgcn_rcpf(1.0f + __expf(-x)); }
#define LDS_WAIT() asm volatile("s_waitcnt lgkmcnt(0)" ::: "memory")

using pg8::Unit;
typedef float accf4 __attribute__((ext_vector_type(4)));

struct EpiInCP {
    static constexpr bool PERM = true, AFTER_DRAIN = false;
    bf16* AG; bf16* UU; const float* ss;
    __device__ __forceinline__ void operator()(const accf4 (&acc)[2][2][4][2], const Unit& u, int wr, int wc, int fr, int fq) const {
        const int row0 = u.pm * 256 + wr * 64 + fr;
#pragma unroll
        for (int ai = 0; ai < 2; ++ai)
#pragma unroll
            for (int m = 0; m < 4; ++m) {
                const int row = row0 + ai * 128 + m * 16;
                const float rs = rsqrtf(ss[row] * (1.0f / D) + EPS);
                if (u.pn < 4) {
                    float o[8];
#pragma unroll
                    for (int n = 0; n < 2; ++n)
#pragma unroll
                        for (int i = 0; i < 4; ++i) { const float v = acc[ai][0][m][n][i] * rs, g = acc[ai][1][m][n][i] * rs; o[4 * n + i] = v * sigmoidf_(g); }
                    v4u w; w.x = pk2(o[0], o[1]); w.y = pk2(o[2], o[3]); w.z = pk2(o[4], o[5]); w.w = pk2(o[6], o[7]);
                    *(v4u*)(AG + (size_t)row * 512 + 128 * u.pn + 32 * wc + 8 * fq) = w;
                } else {
#pragma unroll
                    for (int bj = 0; bj < 2; ++bj) {
                        const accf4 a0 = acc[ai][bj][m][0] * rs, a1 = acc[ai][bj][m][1] * rs;
                        v4u w; w.x = pk2(a0[0], a0[1]); w.y = pk2(a0[2], a0[3]); w.z = pk2(a1[0], a1[1]); w.w = pk2(a1[2], a1[3]);
                        *(v4u*)(UU + (size_t)row * 512 + 256 * (u.pn - 4) + 128 * bj + 32 * wc + 8 * fq) = w;
                    }
                }
            }
    }
};
struct EpiPool {
    static constexpr bool PERM = true, AFTER_DRAIN = false;
    bf16* CAT; const float* scale;
    __device__ __forceinline__ void operator()(const accf4 (&acc)[2][2][4][2], const Unit& u, int wr, int wc, int fr, int fq) const {
        const int row0 = u.pm * 256 + wr * 64 + fr;
#pragma unroll
        for (int bj = 0; bj < 2; ++bj) {
            const int col = 256 * u.pn + 128 * bj + 32 * wc + 8 * fq;
            const accf4 s0 = *(const accf4*)(scale + col), s1 = *(const accf4*)(scale + col + 4);
#pragma unroll
            for (int ai = 0; ai < 2; ++ai)
#pragma unroll
                for (int m = 0; m < 4; ++m) {
                    const int row = row0 + ai * 128 + m * 16;
                    const accf4 a0 = acc[ai][bj][m][0] * s0, a1 = acc[ai][bj][m][1] * s1;
                    v4u w; w.x = pk2(a0[0], a0[1]); w.y = pk2(a0[2], a0[3]); w.z = pk2(a1[0], a1[1]); w.w = pk2(a1[2], a1[3]);
                    *(v4u*)(CAT + (size_t)row * 1024 + 512 + col) = w;
                }
        }
    }
};
struct EpiResid {
    static constexpr bool PERM = true, AFTER_DRAIN = false;
    const float* resid; float* out; bf16* hb; float* ssn;
    __device__ __forceinline__ void operator()(const accf4 (&acc)[2][2][4][2], const Unit& u, int wr, int wc, int fr, int fq) const {
        const int row0 = u.pm * 256 + wr * 64 + fr;
#pragma unroll
        for (int ai = 0; ai < 2; ++ai)
#pragma unroll
            for (int m = 0; m < 4; ++m) {
                const int row = row0 + ai * 128 + m * 16;
                float p = 0.f;
#pragma unroll
                for (int bj = 0; bj < 2; ++bj) {
                    const size_t off = (size_t)row * D + 256 * u.pn + 128 * bj + 32 * wc + 8 * fq;
                    const accf4 r0 = *(const accf4*)(resid + off), r1 = *(const accf4*)(resid + off + 4);
                    const accf4 o0 = r0 + acc[ai][bj][m][0], o1 = r1 + acc[ai][bj][m][1];
                    *(accf4*)(out + off) = o0; *(accf4*)(out + off + 4) = o1;
                    p += (o0[0] * o0[0] + o0[1] * o0[1]) + (o0[2] * o0[2] + o0[3] * o0[3]) + (o1[0] * o1[0] + o1[1] * o1[1]) + (o1[2] * o1[2] + o1[3] * o1[3]);
                    if (hb) { v4u w; w.x = pk2(o0[0], o0[1]); w.y = pk2(o0[2], o0[3]); w.z = pk2(o1[0], o1[1]); w.w = pk2(o1[2], o1[3]); *(v4u*)(hb + off) = w; }
                }
                p += __shfl_xor(p, 16); p += __shfl_xor(p, 32);
                if (fq == 0) atomicAdd(ssn + row, p);
            }
    }
};
struct EpiSwiGLU {
    static constexpr bool PERM = true, AFTER_DRAIN = false;
    bf16* HID; const float* ss;
    __device__ __forceinline__ void operator()(const accf4 (&acc)[2][2][4][2], const Unit& u, int wr, int wc, int fr, int fq) const {
        const int row0 = u.pm * 256 + wr * 64 + fr;
#pragma unroll
        for (int ai = 0; ai < 2; ++ai)
#pragma unroll
            for (int m = 0; m < 4; ++m) {
                const int row = row0 + ai * 128 + m * 16;
                const float rs = rsqrtf(ss[row] * (1.0f / D) + EPS);
                float o[8];
#pragma unroll
                for (int n = 0; n < 2; ++n)
#pragma unroll
                    for (int i = 0; i < 4; ++i) { const float a = acc[ai][0][m][n][i] * rs, b = acc[ai][1][m][n][i] * rs; o[4 * n + i] = a * sigmoidf_(a) * b; }
                v4u w; w.x = pk2(o[0], o[1]); w.y = pk2(o[2], o[3]); w.z = pk2(o[4], o[5]); w.w = pk2(o[6], o[7]);
                *(v4u*)(HID + (size_t)row * FF + 128 * u.pn + 32 * wc + 8 * fq) = w;
            }
    }
};
struct EpiHgIn {
    static constexpr bool PERM = true, AFTER_DRAIN = false;
    bf16* Q; float* Fl; bf16* V; bf16* G; const float* ss; const float* lbl;
    __device__ __forceinline__ void operator()(const accf4 (&acc)[2][2][4][2], const Unit& u, int wr, int wc, int fr, int fq) const {
        const int row0 = u.pm * 256 + wr * 64 + fr, sec = u.pn >> 2, cb = 256 * (u.pn & 3) + 32 * wc + 8 * fq;
        if (sec == 1) {
#pragma unroll
            for (int bj = 0; bj < 2; ++bj) {
                const int col = cb + 128 * bj;
                float lb[8];
#pragma unroll
                for (int j = 0; j < 8; ++j) lb[j] = 1.0f / (1.0f + expf(lbl[col + j] - lbl[D + col + j]));
#pragma unroll
                for (int ai = 0; ai < 2; ++ai)
#pragma unroll
                    for (int m = 0; m < 4; ++m) {
                        const int row = row0 + ai * 128 + m * 16;
                        const float rs = rsqrtf(ss[row] * (1.0f / D) + EPS);
                        accf4 o0, o1;
#pragma unroll
                        for (int i = 0; i < 4; ++i) {
                            const float z0 = acc[ai][bj][m][0][i] * rs, z1 = acc[ai][bj][m][1][i] * rs;
                            o0[i] = logf(lb[i] + (1.0f - lb[i]) * sigmoidf_(z0));
                            o1[i] = logf(lb[4 + i] + (1.0f - lb[4 + i]) * sigmoidf_(z1));
                        }
                        float* p = Fl + (size_t)row * D + col;
                        *(accf4*)p = o0; *(accf4*)(p + 4) = o1;
                    }
            }
        } else {
            bf16* O = Q + (sec ? (size_t)(sec + 1) * (16u << 20) : (size_t)0);
#pragma unroll
            for (int ai = 0; ai < 2; ++ai)
#pragma unroll
                for (int m = 0; m < 4; ++m) {
                    const int row = row0 + ai * 128 + m * 16;
                    const float rs = rsqrtf(ss[row] * (1.0f / D) + EPS);
#pragma unroll
                    for (int bj = 0; bj < 2; ++bj) {
                        accf4 a0 = acc[ai][bj][m][0] * rs, a1 = acc[ai][bj][m][1] * rs;
                        if (sec == 3) {
#pragma unroll
                            for (int i = 0; i < 4; ++i) { a0[i] = a0[i] * sigmoidf_(a0[i]); a1[i] = a1[i] * sigmoidf_(a1[i]); }
                        }
                        v4u w; w.x = pk2(a0[0], a0[1]); w.y = pk2(a0[2], a0[3]); w.z = pk2(a1[0], a1[1]); w.w = pk2(a1[2], a1[3]);
                        *(v4u*)(O + (size_t)row * D + cb + 128 * bj) = w;
                    }
                }
        }
    }
};

#define XB_TMO      128
#define XB_XCNT(j)  (256  + 64 * (j))
#define XB_XSUB(j)  (1280 + 64 * (j))
#define XB_XGEN(j)  (2304 + 64 * (j))
#define XB_TOP      3328
#define XB_TOPGEN   3392
#define XCD_BAR_WORDS 3456
#define XB_SPIN_CAP (1u << 18)

__device__ __forceinline__ unsigned xb_ld(unsigned* p)              { return __hip_atomic_load(p, __ATOMIC_RELAXED, __HIP_MEMORY_SCOPE_AGENT); }
__device__ __forceinline__ unsigned xb_add(unsigned* p, unsigned v) { return __hip_atomic_fetch_add(p, v, __ATOMIC_RELAXED, __HIP_MEMORY_SCOPE_AGENT); }
__device__ __forceinline__ unsigned xb_xcc_id() { return (unsigned)__builtin_amdgcn_s_getreg((3 << 11) | 20) & 0xFu; }
#define XB_SPIN(cond, bar) do { unsigned _sp = 0; while (cond) { __builtin_amdgcn_s_sleep(1); \
    if ((++_sp & 255u) == 0u) { if (xb_ld(&(bar)[XB_TMO])) break; if (_sp > XB_SPIN_CAP) { atomicAdd(&(bar)[XB_TMO], 1u); break; } } } } while (0)

struct XcdBarrier {
    unsigned* bar; unsigned x;
    volatile LAS unsigned* st;
};

__device__ __forceinline__ XcdBarrier xcd_barrier_post(unsigned* bar, volatile LAS unsigned* st) {
    XcdBarrier b; b.bar = bar; b.x = xb_xcc_id(); b.st = st;
    if (threadIdx.x == 0) (void)xb_add(&bar[XB_XCNT(b.x)], 1u);
    return b;
}
__device__ __forceinline__ void xcd_barrier_complete(unsigned* bar, unsigned x, unsigned& nloc, unsigned& nx) {
    const unsigned G = gridDim.x * gridDim.y * gridDim.z;
    unsigned sum, cnt, mine, sp = 0u;
    for (;;) {
        sum = 0u; cnt = 0u; mine = 0u;
#pragma unroll
        for (unsigned j = 0; j < 16; ++j) { const unsigned c = xb_ld(&bar[XB_XCNT(j)]); sum += c; cnt += (c > 0u) ? 1u : 0u; mine = (j == x) ? c : mine; }
        if (sum == G) break;
        __builtin_amdgcn_s_sleep(1);
        if ((++sp & 255u) == 0u) { if (xb_ld(&bar[XB_TMO])) break; if (sp > XB_SPIN_CAP) { atomicAdd(&bar[XB_TMO], 1u); break; } }
    }
    nloc = mine > 0u ? mine : 1u; nx = cnt > 0u ? cnt : 1u;
}

__device__ __forceinline__ void xcd_barrier(const XcdBarrier& b) {
    asm volatile("s_waitcnt vmcnt(0)" ::: "memory");
    __syncthreads();
    if (threadIdx.x == 0) {
        unsigned* bar = b.bar;
        __builtin_amdgcn_s_waitcnt(0);
        unsigned nloc = b.st[0], nx = b.st[1];
        if (nloc == 0u) { xcd_barrier_complete(bar, b.x, nloc, nx); b.st[0] = nloc; b.st[1] = nx; }
        const unsigned old = xb_add(&bar[XB_XSUB(b.x)], 1u);
        const unsigned gen = old / nloc;
        if (old + 1u == (gen + 1u) * nloc) {
            __builtin_amdgcn_fence(__ATOMIC_RELEASE, "agent");
            asm volatile("s_waitcnt vmcnt(0)" ::: "memory");
            const unsigned og = xb_add(&bar[XB_TOP], 1u);
            const unsigned tg = og / nx;
            if (og + 1u == (tg + 1u) * nx) xb_add(&bar[XB_TOPGEN], 1u);
            else XB_SPIN(xb_ld(&bar[XB_TOPGEN]) == tg, bar);
            __builtin_amdgcn_fence(__ATOMIC_ACQUIRE, "agent");
            xb_add(&bar[XB_XGEN(b.x)], 1u);
            asm volatile("s_waitcnt vmcnt(0)" ::: "memory");
        } else {
            XB_SPIN(xb_ld(&bar[XB_XGEN(b.x)]) == gen, bar);
            __builtin_amdgcn_fence(__ATOMIC_ACQUIRE, "agent");
            asm volatile("s_waitcnt vmcnt(0)" ::: "memory");
        }
    }
    __syncthreads();
}
struct Args { const float* in[19]; float* out; unsigned char* ws; };
struct Frame {
    LAS unsigned char* lds;
    int tid, lane, wave, G, bid;
    const float* const* in; float* out; unsigned char* ws;
};

__device__ __forceinline__ void tr_item(const float* W, int N, int k0, int n0, bf16* dst, int ldk, const float* g, LAS float* scr, int lane) {
#pragma unroll 8
    for (int i = 0; i < 32; ++i) { const int kk = 2 * i + (lane >> 5); float w = W[(size_t)(k0 + kk) * N + n0 + (lane & 31)]; if (g) w *= g[k0 + kk]; scr[kk * 33 + (lane & 31)] = w; }
    LDS_WAIT(); asm volatile("" ::: "memory");
    const int c = lane & 7;
#pragma unroll
    for (int j = 0; j < 4; ++j) { const int n = (lane >> 3) + 8 * j; const LAS float* s = scr + (8 * c) * 33 + n;
        v4u o; o.x = pk2(s[0 * 33], s[1 * 33]); o.y = pk2(s[2 * 33], s[3 * 33]); o.z = pk2(s[4 * 33], s[5 * 33]); o.w = pk2(s[6 * 33], s[7 * 33]);
        *(v4u*)(dst + (size_t)n * ldk + 8 * c) = o; }
    LDS_WAIT(); asm volatile("" ::: "memory");
}
__device__ __forceinline__ int map_row(int type, int n0) {
    if (type == 0) return n0;
    if (type == 1) return 256 * (n0 >> 7) + (n0 & 127);
    if (type == 2) return 256 * (n0 >> 7) + 128 + (n0 & 127);
    if (n0 < 512) return 256 * (n0 >> 7) + (n0 & 127);
    if (n0 < 1024) return 256 * ((n0 - 512) >> 7) + 128 + (n0 & 127);
    return n0;
}
__device__ __forceinline__ void tr_job(const float* W, int K, int N, bf16* WT, const float* g, int type, int item, LAS float* scr, int lane) {
    const int nblk = N / 32, kb = item / nblk, nb = item % nblk, k0 = 64 * kb, n0 = 32 * nb;
    tr_item(W, N, k0, n0, WT + (size_t)map_row(type, n0) * K + k0, K, g, scr, lane);
}

__device__ __forceinline__ void p0_prologue(Frame& F) {
    LAS float* scr = (LAS float*)(F.lds + F.wave * 16384);
    const int gw = F.bid * NWAVES + F.wave, NGW = F.G * NWAVES;
    unsigned char* ws = F.ws;
    constexpr int I_IN0 = 16 * 48, I_SQ = 16 * 32, I_UP = 16 * 88, I_DN = 44 * 32, I_HG = 16 * 128;
    constexpr int NITEMS = I_IN0 + I_SQ + 2 * (2 * I_UP + I_DN) + I_HG + I_SQ;
    for (int it = gw; it < NITEMS; it += NGW) {
        int r = it;
        if (r < I_IN0) { tr_job(F.in[4], D, NIN0, (bf16*)(ws + WS_WIN0), F.in[1], 3, r, scr, F.lane); continue; } r -= I_IN0;
        if (r < I_SQ) { tr_job(F.in[11], D, D, (bf16*)(ws + WS_WOUT0), nullptr, 0, r, scr, F.lane); continue; } r -= I_SQ;
        if (r < I_UP) { tr_job(F.in[16], D, FF, (bf16*)(ws + WS_UP0), F.in[2], 1, r, scr, F.lane); continue; } r -= I_UP;
        if (r < I_UP) { tr_job(F.in[17], D, FF, (bf16*)(ws + WS_UP0), F.in[2], 2, r, scr, F.lane); continue; } r -= I_UP;
        if (r < I_DN) { tr_job(F.in[18], FF, D, (bf16*)(ws + WS_DN0), nullptr, 0, r, scr, F.lane); continue; } r -= I_DN;
        if (r < I_HG) { tr_job(F.in[12], D, NHG, (bf16*)(ws + WS_HGIN), F.in[1] + D, 0, r, scr, F.lane); continue; } r -= I_HG;
        if (r < I_SQ) { tr_job(F.in[15], D, D, (bf16*)(ws + WS_HGOUT), nullptr, 0, r, scr, F.lane); continue; } r -= I_SQ;
        if (r < I_UP) { tr_job(F.in[16] + (size_t)D * FF, D, FF, (bf16*)(ws + WS_UP1), F.in[2] + D, 1, r, scr, F.lane); continue; } r -= I_UP;
        if (r < I_UP) { tr_job(F.in[17] + (size_t)D * FF, D, FF, (bf16*)(ws + WS_UP1), F.in[2] + D, 2, r, scr, F.lane); continue; } r -= I_UP;
        tr_job(F.in[18] + (size_t)D * FF, FF, D, (bf16*)(ws + WS_DN1), nullptr, 0, r, scr, F.lane);
    }
    {
        const float* pw = F.in[9]; bf16* PW = (bf16*)(ws + WS_PW);
        for (int e = F.bid * NTHR + F.tid; e < 512 * 512; e += F.G * NTHR) {
            const int n = e >> 9, k = e & 511, g = n >> 7;
            float v = 0.f; if ((k >> 7) == g) v = pw[g * 16384 + (k & 127) * 128 + (n & 127)];
            PW[e] = (bf16)(pk2(v, 0.f) & 0xffffu);
        }
    }
    float* ss = (float*)(ws + WS_SS);
    const float* x = F.in[0]; bf16* HB = (bf16*)(ws + WS_HB);
    for (int m = gw; m < M; m += NGW) {
        const f32x4* xr = (const f32x4*)(x + (size_t)m * D) + F.lane;
        f32x4 v[4]; float s = 0.f;
#pragma unroll
        for (int j = 0; j < 4; ++j) { v[j] = xr[64 * j]; s += (v[j][0] * v[j][0] + v[j][1] * v[j][1]) + (v[j][2] * v[j][2] + v[j][3] * v[j][3]); }
        s = wave_sum(s);
        if (F.lane == 0) ss[m] = s;
        v2u* o8 = (v2u*)(HB + (size_t)m * D) + F.lane;
#pragma unroll
        for (int j = 0; j < 4; ++j) { v2u w; w.x = pk2(v[j][0], v[j][1]); w.y = pk2(v[j][2], v[j][3]); o8[64 * j] = w; }
    }
    for (int e = F.bid * NTHR + F.tid; e < 4 * M; e += F.G * NTHR) ss[M + e] = 0.f;
}

__device__ __forceinline__ void phase_convpool(Frame& F) {
    LAS float* wl = (LAS float*)F.lds;
    LAS unsigned char* at = F.lds + 63488;
    const float* dw_w = F.in[5]; const float* dw_b = F.in[6]; const float* ln_g = F.in[7]; const float* ln_b = F.in[8];
    const bf16* AG = (const bf16*)(F.ws + WS_AG); const bf16* UU = (const bf16*)(F.ws + WS_UU);
    bf16* CAT = (bf16*)(F.ws + WS_CAT); bf16* DD = (bf16*)(F.ws + WS_DD);
    const int tid = F.tid, lane = F.lane, w = F.wave;
    for (int e = tid; e < 31 * 128; e += NTHR) { const int j = e >> 7, q4 = e & 127;
        const f32x4 v = *(const f32x4*)(dw_w + j * 512 + 4 * q4);
        *(LAS f32x4*)(wl + ((j * 2 + (q4 & 1)) * 64 + (q4 >> 1)) * 4) = v; }
    const int PW_ = 2 << (lane >> 4);
    for (int tile = F.bid; tile < M / 32; tile += F.G) {
        const int m0 = tile * 32, tpos0 = m0 & (T - 1);
        __syncthreads();
        for (int e = tid; e < 64 * 64; e += NTHR) { const int rr = e >> 6, ch = e & 63; v4u v = (v4u){0u, 0u, 0u, 0u};
            if (tpos0 - 30 + rr >= 0 && rr < 62) v = *(const v4u*)(AG + (size_t)(m0 - 30 + rr) * 512 + ch * 8);
            *(LAS v4u*)(at + rr * 1024 + ch * 16) = v; }
        __syncthreads();
        float acc[4][8];
        {
            const f32x4 b0 = *(const f32x4*)(dw_b + lane * 8), b1 = *(const f32x4*)(dw_b + lane * 8 + 4);
#pragma unroll
            for (int tt = 0; tt < 4; ++tt)
#pragma unroll
                for (int i = 0; i < 4; ++i) { acc[tt][i] = b0[i]; acc[tt][4 + i] = b1[i]; }
        }
        float wreg[4][8];
#pragma unroll
        for (int rr = 0; rr < 4; ++rr)
#pragma unroll
            for (int i = 0; i < 8; ++i) wreg[rr][i] = 0.f;
#pragma unroll 1
        for (int rb = 0; rb < 9; ++rb) {
#pragma unroll
            for (int rr = 0; rr < 4; ++rr) {
                const int r = 4 * rb + rr;
                const v4u av = *(const LAS v4u*)(at + (4 * w + r) * 1024 + lane * 16);
                float a[8]; a[0] = bflo(av.x); a[1] = bfhi(av.x); a[2] = bflo(av.y); a[3] = bfhi(av.y); a[4] = bflo(av.z); a[5] = bfhi(av.z); a[6] = bflo(av.w); a[7] = bfhi(av.w);
                f32x4 w0 = (f32x4){0.f, 0.f, 0.f, 0.f}, w1 = w0;
                if (r <= 30) { w0 = *(const LAS f32x4*)(wl + ((r * 2 + 0) * 64 + lane) * 4); w1 = *(const LAS f32x4*)(wl + ((r * 2 + 1) * 64 + lane) * 4); }
#pragma unroll
                for (int i = 0; i < 4; ++i) { wreg[rr][i] = w0[i]; wreg[rr][4 + i] = w1[i]; }
#pragma unroll
                for (int tt = 0; tt < 4; ++tt) {
#pragma unroll
                    for (int i = 0; i < 8; ++i) acc[tt][i] += wreg[(rr - tt) & 3][i] * a[i]; }
            }
        }
        float lg[8], lb[8];
        {
            const f32x4 g0 = *(const f32x4*)(ln_g + lane * 8), g1 = *(const f32x4*)(ln_g + lane * 8 + 4), c0 = *(const f32x4*)(ln_b + lane * 8), c1 = *(const f32x4*)(ln_b + lane * 8 + 4);
#pragma unroll
            for (int i = 0; i < 4; ++i) { lg[i] = g0[i]; lg[4 + i] = g1[i]; lb[i] = c0[i]; lb[4 + i] = c1[i]; }
        }
#pragma unroll
        for (int tt = 0; tt < 4; ++tt) {
            float s = 0.f;
#pragma unroll
            for (int i = 0; i < 8; ++i) s += acc[tt][i];
            const float mean = wave_sum(s) * (1.0f / 512.0f);
            float q = 0.f;
#pragma unroll
            for (int i = 0; i < 8; ++i) { acc[tt][i] -= mean; q += acc[tt][i] * acc[tt][i]; }
            const float rstd = rsqrtf(wave_sum(q) * (1.0f / 512.0f) + EPS);
            float o[8];
#pragma unroll
            for (int i = 0; i < 8; ++i) { const float y = acc[tt][i] * rstd * lg[i] + lb[i]; o[i] = y * sigmoidf_(y); }
            v4u wv; wv.x = pk2(o[0], o[1]); wv.y = pk2(o[2], o[3]); wv.z = pk2(o[4], o[5]); wv.w = pk2(o[6], o[7]);
            *(v4u*)(CAT + (size_t)(m0 + 4 * w + tt) * 1024 + lane * 8) = wv;
        }
        {
            const int mb = m0 + 4 * w, tb = tpos0 + 4 * w;
            float sum[4][8], self[4][8];
#pragma unroll
            for (int tt = 0; tt < 4; ++tt)
#pragma unroll
                for (int i = 0; i < 8; ++i) { sum[tt][i] = 0.f; self[tt][i] = 0.f; }
#pragma unroll
            for (int r = 0; r < 19; ++r) {
                if (tb - 15 + r < 0) continue;
                const v4u uv = *(const v4u*)(UU + (size_t)(mb - 15 + r) * 512 + lane * 8);
                float a[8]; a[0] = bflo(uv.x); a[1] = bfhi(uv.x); a[2] = bflo(uv.y); a[3] = bfhi(uv.y); a[4] = bflo(uv.z); a[5] = bfhi(uv.z); a[6] = bflo(uv.w); a[7] = bfhi(uv.w);
#pragma unroll
                for (int tt = 0; tt < 4; ++tt) { const int i_ = 15 + tt - r; if (i_ >= 0 && i_ < 16) {
                    const bool in = i_ < PW_;
#pragma unroll
                    for (int i = 0; i < 8; ++i) { sum[tt][i] += in ? a[i] : 0.f; if (i_ == 0) self[tt][i] = a[i]; } } }
            }
#pragma unroll
            for (int tt = 0; tt < 4; ++tt) {
                const int tp = tb + tt; const int cnt = (tp + 1) < PW_ ? (tp + 1) : PW_;
                const float inv = 1.0f / (float)cnt;
                float o[8];
#pragma unroll
                for (int i = 0; i < 8; ++i) o[i] = sum[tt][i] * inv - self[tt][i];
                v4u wv; wv.x = pk2(o[0], o[1]); wv.y = pk2(o[2], o[3]); wv.z = pk2(o[4], o[5]); wv.w = pk2(o[6], o[7]);
                *(v4u*)(DD + (size_t)(mb + tt) * 512 + lane * 8) = wv;
            }
        }
    }
    __syncthreads();
}

constexpr int KT_P = 72;
constexpr int QS_P = 136;
__device__ __forceinline__ void phase_hg_state(Frame& F) {
    LAS float* Bf = (LAS float*)F.lds;
    LAS float* tot = (LAS float*)(F.lds + 32768);
    LAS bf16* KT = (LAS bf16*)(F.lds + 34816);
    LAS bf16* VT = (LAS bf16*)(F.lds + 34816 + 128 * KT_P * 2);
    const float* Fl = (const float*)(F.ws + WS_F); const bf16* V = (const bf16*)(F.ws + WS_V);
    bf16* U = (bf16*)(F.ws + WS_U); float* DEC = (float*)(F.ws + WS_DEC);
    const int tid = F.tid, lane = F.lane, w = F.wave, c = tid & 127, qd = tid >> 7, l16 = lane & 15, lq = lane >> 4;
    for (int unit = F.bid; unit < 2048; unit += F.G) {
        const int bh = unit >> 6, chunk = unit & 63, b = bh >> 3, h = bh & 7;
        const size_t m0 = (size_t)b * T + chunk * 64; const int c0 = h * 128;
        __syncthreads();
        for (int e = tid; e < 2048; e += NTHR) { const int s = e >> 5, c4 = e & 31;
            *(LAS f32x4*)(Bf + s * 128 + c4 * 4) = *(const f32x4*)(Fl + (m0 + s) * D + c0 + c4 * 4); }
        unsigned vv[8];
#pragma unroll
        for (int i = 0; i < 8; ++i) { const unsigned lo = V[(m0 + 16 * qd + 2 * i) * D + c0 + c], hi = V[(m0 + 16 * qd + 2 * i + 1) * D + c0 + c]; vv[i] = lo | (hi << 16); }
        __syncthreads();
        float lf[16], bs[16]; float run = 0.f;
#pragma unroll
        for (int i = 0; i < 16; ++i) { lf[i] = Bf[(16 * qd + i) * 128 + c]; run += lf[i]; bs[i] = run; }
        tot[qd * 128 + c] = run;
        __syncthreads();
        float pre = 0.f, total = 0.f;
#pragma unroll
        for (int q = 0; q < 4; ++q) { const float t = tot[q * 128 + c]; total += t; if (q < qd) pre += t; }
        unsigned kk[8];
#pragma unroll
        for (int i = 0; i < 8; ++i) {
            const float b0 = bs[2 * i] + pre, b1 = bs[2 * i + 1] + pre;
            const float k0 = (1.0f - __expf(lf[2 * i])) * __expf(total - b0), k1 = (1.0f - __expf(lf[2 * i + 1])) * __expf(total - b1);
            kk[i] = pk2(k0, k1);
        }
        *(LAS v4u*)(KT + c * KT_P + 16 * qd) = (v4u){kk[0], kk[1], kk[2], kk[3]};
        *(LAS v4u*)(KT + c * KT_P + 16 * qd + 8) = (v4u){kk[4], kk[5], kk[6], kk[7]};
        *(LAS v4u*)(VT + c * KT_P + 16 * qd) = (v4u){vv[0], vv[1], vv[2], vv[3]};
        *(LAS v4u*)(VT + c * KT_P + 16 * qd + 8) = (v4u){vv[4], vv[5], vv[6], vv[7]};
        if (qd == 3) DEC[(size_t)unit * 128 + c] = __expf(total);
        __syncthreads();
        const bf16x8 a0 = *(const LAS bf16x8*)(KT + (16 * w + l16) * KT_P + 8 * lq), a1 = *(const LAS bf16x8*)(KT + (16 * w + l16) * KT_P + 8 * lq + 32);
#pragma unroll
        for (int vb = 0; vb < 8; ++vb) {
            const bf16x8 b0 = *(const LAS bf16x8*)(VT + (16 * vb + l16) * KT_P + 8 * lq), b1 = *(const LAS bf16x8*)(VT + (16 * vb + l16) * KT_P + 8 * lq + 32);
            f32x4 acc = (f32x4){0.f, 0.f, 0.f, 0.f};
            acc = __builtin_amdgcn_mfma_f32_16x16x32_bf16(a0, b0, acc, 0, 0, 0);
            acc = __builtin_amdgcn_mfma_f32_16x16x32_bf16(a1, b1, acc, 0, 0, 0);
            v2u o; o.x = pk2(acc[0], acc[1]); o.y = pk2(acc[2], acc[3]);
            *(v2u*)(U + ((size_t)unit * 128 + 16 * vb + l16) * 128 + 16 * w + 4 * lq) = o;
        }
    }
    __syncthreads();
}
__device__ __forceinline__ void phase_hg_scan(Frame& F) {
    bf16* U = (bf16*)(F.ws + WS_U); const float* DEC = (const float*)(F.ws + WS_DEC);
    for (int it = F.bid * NTHR + F.tid; it < 32 * 128 * 32; it += F.G * NTHR) {
        const int bh = it >> 12, v = (it >> 5) & 127, k4 = (it & 31) * 4;
        bf16* up = U + ((size_t)(bh * 64) * 128 + v) * 128 + k4;
        const float* dp = DEC + (size_t)(bh * 64) * 128 + k4;
        float S0 = 0.f, S1 = 0.f, S2 = 0.f, S3 = 0.f;
        for (int cb = 0; cb < 64; cb += 8) {
            v2u uu[8]; f32x4 dd[8];
#pragma unroll
            for (int j = 0; j < 8; ++j) { uu[j] = *(const v2u*)(up + (size_t)(cb + j) * 16384); dd[j] = *(const f32x4*)(dp + (cb + j) * 128); }
#pragma unroll
            for (int j = 0; j < 8; ++j) {
                v2u o; o.x = pk2(S0, S1); o.y = pk2(S2, S3);
                *(v2u*)(up + (size_t)(cb + j) * 16384) = o;
                S0 = dd[j][0] * S0 + bflo(uu[j].x); S1 = dd[j][1] * S1 + bfhi(uu[j].x); S2 = dd[j][2] * S2 + bflo(uu[j].y); S3 = dd[j][3] * S3 + bfhi(uu[j].y);
            }
        }
    }
}
__device__ __forceinline__ void phase_hg_out(Frame& F) {
    LAS float* Bf = (LAS float*)F.lds;
    LAS float* tot = (LAS float*)(F.lds + 32768);
    LAS bf16* Qs = (LAS bf16*)(F.lds + 34816);
    LAS bf16* Ks = (LAS bf16*)(F.lds + 52224);
    LAS bf16* VT = (LAS bf16*)(F.lds + 69632);
    LAS bf16* Sc = (LAS bf16*)(F.lds + 88064);
    LAS float* part = (LAS float*)(F.lds + 97280);
    const float* Fl = (const float*)(F.ws + WS_F); const bf16* V = (const bf16*)(F.ws + WS_V); const bf16* G = (const bf16*)(F.ws + WS_G);
    bf16* Q = (bf16*)(F.ws + WS_Q); const bf16* U = (const bf16*)(F.ws + WS_U); const float* gn = F.in[14];
    const int tid = F.tid, lane = F.lane, w = F.wave, c = tid & 127, qd = tid >> 7, l16 = lane & 15, lq = lane >> 4;
    for (int unit = F.bid; unit < 2048; unit += F.G) {
        const int bh = unit >> 6, chunk = unit & 63, b = bh >> 3, h = bh & 7;
        const size_t m0 = (size_t)b * T + chunk * 64; const int c0 = h * 128;
        __syncthreads();
        for (int e = tid; e < 2048; e += NTHR) { const int s = e >> 5, c4 = e & 31;
            *(LAS f32x4*)(Bf + s * 128 + c4 * 4) = *(const f32x4*)(Fl + (m0 + s) * D + c0 + c4 * 4); }
        unsigned vv[8], qq[8];
#pragma unroll
        for (int i = 0; i < 8; ++i) {
            const size_t o0 = (m0 + 16 * qd + 2 * i) * D + c0 + c, o1 = o0 + D;
            vv[i] = (unsigned)V[o0] | ((unsigned)V[o1] << 16); qq[i] = (unsigned)Q[o0] | ((unsigned)Q[o1] << 16);
        }
        bf16x8 st[4];
#pragma unroll
        for (int kk = 0; kk < 4; ++kk) st[kk] = *(const bf16x8*)(U + ((size_t)unit * 128 + 16 * w + l16) * 128 + 8 * lq + 32 * kk);
        __syncthreads();
        float lf[16], bs[16]; float run = 0.f;
#pragma unroll
        for (int i = 0; i < 16; ++i) { lf[i] = Bf[(16 * qd + i) * 128 + c]; run += lf[i]; bs[i] = run; }
        tot[qd * 128 + c] = run;
        __syncthreads();
        float pre = 0.f;
#pragma unroll
        for (int q = 0; q < 4; ++q) { const float t = tot[q * 128 + c]; if (q < qd) pre += t; }
#pragma unroll
        for (int i = 0; i < 16; ++i) {
            const float bb = bs[i] + pre;
            const float qv = ((i & 1) ? bfhi(qq[i >> 1]) : bflo(qq[i >> 1])) * __expf(bb);
            const float kv = (1.0f - __expf(lf[i])) * __expf(-bb);
            const unsigned pq = pk2(qv, kv);
            Qs[(16 * qd + i) * QS_P + c] = (bf16)(pq & 0xffffu);
            Ks[(16 * qd + i) * QS_P + c] = (bf16)(pq >> 16);
        }
        *(LAS v4u*)(VT + c * KT_P + 16 * qd) = (v4u){vv[0], vv[1], vv[2], vv[3]};
        *(LAS v4u*)(VT + c * KT_P + 16 * qd + 8) = (v4u){vv[4], vv[5], vv[6], vv[7]};
        __syncthreads();
        {
            const int tb = w >> 1;
            bf16x8 qf[4];
#pragma unroll
            for (int kk = 0; kk < 4; ++kk) qf[kk] = *(const LAS bf16x8*)(Qs + (16 * tb + l16) * QS_P + 8 * lq + 32 * kk);
#pragma unroll
            for (int j = 0; j < 2; ++j) {
                const int sb = 2 * (w & 1) + j;
                f32x4 acc = (f32x4){0.f, 0.f, 0.f, 0.f};
                if (sb <= tb) {
#pragma unroll
                    for (int kk = 0; kk < 4; ++kk) { const bf16x8 kf = *(const LAS bf16x8*)(Ks + (16 * sb + l16) * QS_P + 8 * lq + 32 * kk);
                        acc = __builtin_amdgcn_mfma_f32_16x16x32_bf16(kf, qf[kk], acc, 0, 0, 0); }
                    const int t = 16 * tb + l16, s0 = 16 * sb + 4 * lq;
#pragma unroll
                    for (int i = 0; i < 4; ++i) if (s0 + i > t) acc[i] = 0.f;
                }
                v2u o; o.x = pk2(acc[0], acc[1]); o.y = pk2(acc[2], acc[3]);
                *(LAS v2u*)(Sc + (16 * tb + l16) * KT_P + 16 * sb + 4 * lq) = o;
            }
        }
        __syncthreads();
        f32x4 oacc[4];
        {
            const bf16x8 vf0 = *(const LAS bf16x8*)(VT + (16 * w + l16) * KT_P + 8 * lq), vf1 = *(const LAS bf16x8*)(VT + (16 * w + l16) * KT_P + 8 * lq + 32);
#pragma unroll
            for (int tb = 0; tb < 4; ++tb) {
                f32x4 acc = (f32x4){0.f, 0.f, 0.f, 0.f};
#pragma unroll
                for (int kk = 0; kk < 4; ++kk) { const bf16x8 qf = *(const LAS bf16x8*)(Qs + (16 * tb + l16) * QS_P + 8 * lq + 32 * kk);
                    acc = __builtin_amdgcn_mfma_f32_16x16x32_bf16(st[kk], qf, acc, 0, 0, 0); }
                const bf16x8 s0 = *(const LAS bf16x8*)(Sc + (16 * tb + l16) * KT_P + 8 * lq), s1 = *(const LAS bf16x8*)(Sc + (16 * tb + l16) * KT_P + 8 * lq + 32);
                acc = __builtin_amdgcn_mfma_f32_16x16x32_bf16(vf0, s0, acc, 0, 0, 0);
                acc = __builtin_amdgcn_mfma_f32_16x16x32_bf16(vf1, s1, acc, 0, 0, 0);
                oacc[tb] = acc;
                float p = (acc[0] * acc[0] + acc[1] * acc[1]) + (acc[2] * acc[2] + acc[3] * acc[3]);
                p += __shfl_xor(p, 16); p += __shfl_xor(p, 32);
                if (lane < 16) part[w * 64 + 16 * tb + lane] = p;
            }
        }
        __syncthreads();
        {
            const f32x4 gv = *(const f32x4*)(gn + c0 + 16 * w + 4 * lq);
#pragma unroll
            for (int tb = 0; tb < 4; ++tb) {
                const int t = 16 * tb + l16;
                float s = 0.f;
#pragma unroll
                for (int ww = 0; ww < 8; ++ww) s += part[ww * 64 + t];
                const float rstd = rsqrtf(s * (1.0f / 128.0f) + EPS);
                const size_t off = (m0 + t) * D + c0 + 16 * w + 4 * lq;
                const v2u gg = *(const v2u*)(G + off);
                v2u o; o.x = pk2(oacc[tb][0] * rstd * gv[0] * bflo(gg.x), oacc[tb][1] * rstd * gv[1] * bfhi(gg.x));
                o.y = pk2(oacc[tb][2] * rstd * gv[2] * bflo(gg.y), oacc[tb][3] * rstd * gv[3] * bfhi(gg.y));
                *(v2u*)(Q + off) = o;
            }
        }
    }
    __syncthreads();
}
__device__ __forceinline__ void phase_final(Frame& F) {
    const float* ss = (const float*)(F.ws + WS_SS) + 4 * M; const float* fg = F.in[3];
    const int gw = F.bid * NWAVES + F.wave, NGW = F.G * NWAVES;
    f32x4 g[4];
#pragma unroll
    for (int j = 0; j < 4; ++j) g[j] = *((const f32x4*)fg + F.lane + 64 * j);
    for (int m = gw; m < M; m += NGW) {
        const float rs = rsqrtf(ss[m] * (1.0f / D) + EPS);
        f32x4* xr = (f32x4*)(F.out + (size_t)m * D) + F.lane;
#pragma unroll
        for (int j = 0; j < 4; ++j) { f32x4 v = xr[64 * j]; v = v * rs * g[j]; xr[64 * j] = v; }
    }
}


#ifdef STOP_AFTER
__device__ __forceinline__ void dbg_dump(Frame& F, int k) {
    unsigned char* ws = F.ws;
    for (size_t i = (size_t)F.bid * NTHR + F.tid; i < (size_t)M * D; i += (size_t)F.G * NTHR) {
        const size_t m = i >> 10; const int c = (int)(i & 1023);
        float v = 0.f;
        if (k == 0) v = __uint_as_float((unsigned)((const bf16*)(ws + WS_HB))[i] << 16) + ((const float*)(ws + WS_SS))[m] * 1e-3f + __uint_as_float((unsigned)((const bf16*)(ws + WS_UP1))[i] << 16) + __uint_as_float((unsigned)((const bf16*)(ws + WS_HGIN))[i] << 16);
        else if (k == 1) v = c < 512 ? __uint_as_float((unsigned)((const bf16*)(ws + WS_AG))[m * 512 + c] << 16) : __uint_as_float((unsigned)((const bf16*)(ws + WS_UU))[m * 512 + c - 512] << 16);
        else if (k == 2) v = c < 512 ? __uint_as_float((unsigned)((const bf16*)(ws + WS_CAT))[m * 1024 + c] << 16) : __uint_as_float((unsigned)((const bf16*)(ws + WS_DD))[m * 512 + c - 512] << 16);
        else if (k == 3) v = __uint_as_float((unsigned)((const bf16*)(ws + WS_CAT))[i] << 16);
        else if (k == 4) v = F.out[i] + __uint_as_float((unsigned)((const bf16*)(ws + WS_HB))[i] << 16) + ((const float*)(ws + WS_SS))[M + m] * 1e-3f;
        else if (k == 5) v = __uint_as_float((unsigned)((const bf16*)(ws + WS_HID))[m * FF + c] << 16) + __uint_as_float((unsigned)((const bf16*)(ws + WS_HID))[m * FF + 1024 + c] << 16) + __uint_as_float((unsigned)((const bf16*)(ws + WS_HID))[m * FF + 1792 + c] << 16);
        else if (k == 6) v = F.out[i];
        else if (k == 7) v = __uint_as_float((unsigned)((const bf16*)(ws + WS_Q))[i] << 16) + ((const float*)(ws + WS_F))[i] + __uint_as_float((unsigned)((const bf16*)(ws + WS_V))[i] << 16) + __uint_as_float((unsigned)((const bf16*)(ws + WS_G))[i] << 16);
        else if (k == 8 || k == 9) v = __uint_as_float((unsigned)((const bf16*)(ws + WS_U))[i] << 16) + __uint_as_float((unsigned)((const bf16*)(ws + WS_U))[i + (size_t)M * D] << 16) + ((const float*)(ws + WS_DEC))[i & 262143];
        else if (k == 10) v = __uint_as_float((unsigned)((const bf16*)(ws + WS_Q))[i] << 16);
        else v = F.out[i];
        F.out[i] = v;
    }
}
#define DBG_STOP(k) do { if (STOP_AFTER == (k)) { if ((k) == 4 || (k) == 6 || (k) >= 11) {   } dbg_dump(F, (k)); return; } } while (0)
#else
#define DBG_STOP(k) do { } while (0)
#endif
#define GEMM_PHASE(EPI, Aptr, Bptr, NN, KK, E) do { pg8::Gemm g_{(const pg8::bf16_t*)(Aptr), (const pg8::bf16_t*)(Bptr), M, (NN), (KK)}; pg8::StaticOrder S_; S_.init(M, (NN), F.G, F.bid); \
        pg8::gemm_phase<EPI, pg8::StaticOrder, true, true>(F.lds, g_, S_, (E)); } while (0)

__global__ void __launch_bounds__(NTHR, 2) trunk_fwd(Args args) {
    extern __shared__ __attribute__((aligned(16))) unsigned char lds_raw[];
    Frame F;
    F.lds = (LAS unsigned char*)lds_raw;
    F.tid = threadIdx.x; F.lane = F.tid & 63; F.wave = __builtin_amdgcn_readfirstlane(F.tid >> 6);
    F.G = gridDim.x; F.bid = blockIdx.x;
    F.in = args.in; F.out = args.out; F.ws = args.ws;
    unsigned char* ws = args.ws;
    float* ss = (float*)(ws + WS_SS);
    bf16* HB = (bf16*)(ws + WS_HB);

    for (int u = F.tid; u < (LDS_BYTES - LDSCTL_OFF) / 4; u += NTHR) ((LAS unsigned*)(F.lds + LDSCTL_OFF))[u] = 0u;
    __syncthreads();
    XcdBarrier bar = xcd_barrier_post((unsigned*)(ws + WS_CTL), (volatile LAS unsigned*)(F.lds + MISC_OFF) + 8);
    cg::this_grid().sync();
#define GRID_SYNC() xcd_barrier(bar)
#if !defined(PHMASK) || (PHMASK & (1 << 0))
    p0_prologue(F);
#endif
    GRID_SYNC();
    DBG_STOP(0);
#if !defined(PHMASK) || (PHMASK & (1 << 1))
    { EpiInCP E{(bf16*)(ws + WS_AG), (bf16*)(ws + WS_UU), ss}; GEMM_PHASE(EpiInCP, HB, ws + WS_WIN0, NIN0, D, E); }
#endif
    GRID_SYNC();
    DBG_STOP(1);
#if !defined(PHMASK) || (PHMASK & (1 << 2))
    phase_convpool(F);
#endif
    GRID_SYNC();
    DBG_STOP(2);
#if !defined(PHMASK) || (PHMASK & (1 << 3))
    { EpiPool E{(bf16*)(ws + WS_CAT), F.in[10]}; GEMM_PHASE(EpiPool, ws + WS_DD, ws + WS_PW, 512, 512, E); }
#endif
    GRID_SYNC();
    DBG_STOP(3);
#if !defined(PHMASK) || (PHMASK & (1 << 4))
    { EpiResid E{F.in[0], F.out, HB, ss + M}; GEMM_PHASE(EpiResid, ws + WS_CAT, ws + WS_WOUT0, D, D, E); }
#endif
    GRID_SYNC();
    DBG_STOP(4);
#if !defined(PHMASK) || (PHMASK & (1 << 5))
    { EpiSwiGLU E{(bf16*)(ws + WS_HID), ss + M}; GEMM_PHASE(EpiSwiGLU, HB, ws + WS_UP0, NUP, D, E); }
#endif
    GRID_SYNC();
    DBG_STOP(5);
#if !defined(PHMASK) || (PHMASK & (1 << 6))
    { EpiResid E{F.out, F.out, HB, ss + 2 * M}; GEMM_PHASE(EpiResid, ws + WS_HID, ws + WS_DN0, D, FF, E); }
#endif
    GRID_SYNC();
    DBG_STOP(6);
#if !defined(PHMASK) || (PHMASK & (1 << 7))
    { EpiHgIn E{(bf16*)(ws + WS_Q), (float*)(ws + WS_F), (bf16*)(ws + WS_V), (bf16*)(ws + WS_G), ss + 2 * M, F.in[13]}; GEMM_PHASE(EpiHgIn, HB, ws + WS_HGIN, NHG, D, E); }
#endif
    GRID_SYNC();
    DBG_STOP(7);
#if !defined(PHMASK) || (PHMASK & (1 << 8))
    phase_hg_state(F);
#endif
    GRID_SYNC();
    DBG_STOP(8);
#if !defined(PHMASK) || (PHMASK & (1 << 9))
    phase_hg_scan(F);
#endif
    GRID_SYNC();
    DBG_STOP(9);
#if !defined(PHMASK) || (PHMASK & (1 << 10))
    phase_hg_out(F);
#endif
    GRID_SYNC();
    DBG_STOP(10);
#if !defined(PHMASK) || (PHMASK & (1 << 11))
    { EpiResid E{F.out, F.out, HB, ss + 3 * M}; GEMM_PHASE(EpiResid, ws + WS_Q, ws + WS_HGOUT, D, D, E); }
#endif
    GRID_SYNC();
    DBG_STOP(11);
#if !defined(PHMASK) || (PHMASK & (1 << 12))
    { EpiSwiGLU E{(bf16*)(ws + WS_HID), ss + 3 * M}; GEMM_PHASE(EpiSwiGLU, HB, ws + WS_UP1, NUP, D, E); }
#endif
    GRID_SYNC();
    DBG_STOP(12);
#if !defined(PHMASK) || (PHMASK & (1 << 13))
    { EpiResid E{F.out, F.out, nullptr, ss + 4 * M}; GEMM_PHASE(EpiResid, ws + WS_HID, ws + WS_DN1, D, FF, E); }
#endif
    GRID_SYNC();
    DBG_STOP(13);
#if !defined(PHMASK) || (PHMASK & (1 << 14))
    phase_final(F);
#endif
}

extern "C" void kernel_launch(void* const* d_in, const int* in_sizes, int n_in, void* d_out, int out_size, void* d_ws, size_t ws_size, hipStream_t stream) {
    static int grid = 0;
    if (grid == 0) {
        if (n_in != 19 || out_size != M * D || ws_size < WS_END) { fprintf(stderr, "kernel_launch: unexpected shapes (n_in %d out %d ws %zu)\n", n_in, out_size, ws_size); grid = -1; return; }
        int dev = 0, cus = 0, per_cu = 0;
        (void)hipGetDevice(&dev);
        (void)hipDeviceGetAttribute(&cus, hipDeviceAttributeMultiprocessorCount, dev);
        if (hipFuncSetAttribute((const void*)trunk_fwd, hipFuncAttributeMaxDynamicSharedMemorySize, LDS_BYTES) != hipSuccess) { fprintf(stderr, "kernel_launch: hipFuncSetAttribute failed\n"); grid = -1; return; }
        if (hipOccupancyMaxActiveBlocksPerMultiprocessor(&per_cu, (const void*)trunk_fwd, NTHR, LDS_BYTES) != hipSuccess || per_cu < 1) { fprintf(stderr, "kernel_launch: occupancy query says %d\n", per_cu); per_cu = 1; }
        (void)hipGetLastError();
        grid = cus * 1;
        if (grid > cus * per_cu) grid = cus * per_cu;
        fprintf(stderr, "kernel_launch: grid %d (cus %d, per_cu %d)\n", grid, cus, per_cu);
    }
    if (grid < 0) return;
    if (hipMemsetAsync((char*)d_ws + WS_CTL, 0, CTL_ZERO_BYTES, stream) != hipSuccess) { fprintf(stderr, "kernel_launch: memset failed\n"); return; }
    Args a{};
    for (int i = 0; i < 19; ++i) a.in[i] = (const float*)d_in[i];
    a.out = (float*)d_out; a.ws = (unsigned char*)d_ws;
    void* kargs[] = {&a};
    hipError_t e = hipLaunchCooperativeKernel((const void*)trunk_fwd, dim3(grid), dim3(NTHR), kargs, LDS_BYTES, stream);
    if (e != hipSuccess) fprintf(stderr, "kernel_launch: cooperative launch failed: %s (grid %d)\n", hipGetErrorString(e), grid);
}
```

```cpp
#include <hip/hip_runtime.h>
#include <hip/hip_cooperative_groups.h>
#include <cstdio>
#include <cstdint>
namespace cg = cooperative_groups;
namespace pg8 {
#define PG8_LAS __attribute__((address_space(3)))
typedef unsigned short bf16_t;
typedef short bf16x8 __attribute__((ext_vector_type(8)));
typedef float f32x4 __attribute__((ext_vector_type(4)));
typedef unsigned u32x4 __attribute__((ext_vector_type(4)));
constexpr int BM = 256, BK = 64, HALF = 128, HTB = HALF * BK * 2  , STAGE_BYTES = 8 * HTB, NXCD = 8, WGM = 8;

__host__ __device__ __forceinline__ int lds_byte(int r, int c) { const int st = (r >> 4) * 2 + (c >> 5), rr = r & 15, cc = c & 31, ob = rr * 64 + cc * 2; return st * 1024 + (ob ^ (((ob >> 9) & 1) << 5)); }
__host__ __device__ __forceinline__ void stage_rc(int b, int& R, int& C) { const int st = b / 1024, sb = b % 1024, swz = sb ^ (((sb >> 9) & 1) << 5); R = (st >> 1) * 16 + swz / 64; C = (st & 1) * 32 + (swz % 64) / 2; }
__host__ __device__ __forceinline__ int perm32(int rho) { const int n = rho >> 4, i = rho & 15; return 8 * (i >> 2) + 4 * n + (i & 3); }

struct Unit { int pm, pn; };
struct Gemm { const bf16_t* A; const bf16_t* Bt; int M, N, K; };

struct StaticOrder {
    int nM, nN, nwg, G, c;
    __host__ __device__ void init(int M, int N, int G_, int c_) { nM = M / BM; nN = N / BM; nwg = nM * nN; G = G_; c = c_; }
    __host__ __device__ bool next(int i, Unit& u) const {
        const long L = (long)i * G + c; if (L >= nwg) return false;
        int wgid = (int)L; { const int q = nwg / NXCD, r = nwg % NXCD, xcd = wgid % NXCD, off = wgid / NXCD; wgid = (xcd < r ? xcd * (q + 1) : r * (q + 1) + (xcd - r) * q) + off; }
        const int nig = WGM * nN, gid = wgid / nig, fm = gid * WGM, gsz = (nM - fm) < WGM ? (nM - fm) : WGM;
        u.pm = fm + ((wgid % nig) % gsz); u.pn = (wgid % nig) / gsz; return true;
    }
    __device__ __forceinline__ void a_ready(const Unit&) const {}
    __device__ __forceinline__ void done(const Unit&) const {}
};

__device__ __forceinline__ unsigned cvt_pk_bf16(float lo, float hi) { unsigned r; asm volatile("v_cvt_pk_bf16_f32 %0, %1, %2" : "=v"(r) : "v"(lo), "v"(hi)); return r; }
template <class Epi, class Sched, bool ALIGN_EPI = false, bool SP2 = false>
__device__ __forceinline__ void gemm_phase(PG8_LAS unsigned char* lds, const Gemm g, const Sched& S, const Epi& E) {
    const int tid = threadIdx.x, wid = __builtin_amdgcn_readfirstlane(tid >> 6), lane = tid & 63, wr = wid >> 2, wc = wid & 3, fr = lane & 15, fq = lane >> 4;
    const int K = g.K, nt = K / BK;
    unsigned voffA[2], voffB[2];
#pragma unroll
    for (int i = 0; i < 2; ++i) { int R, C; stage_rc(tid * 16 + i * 8192, R, C); const int Rb = Epi::PERM ? ((R & ~31) + perm32(R & 31)) : R;
        voffA[i] = (unsigned)(R * K + C) * 2u; voffB[i] = (unsigned)(Rb * K + C) * 2u; }
    const size_t kstep = (size_t)(BK * 2);
    const size_t hstep = (size_t)HALF * K * 2;
    const size_t tstep = 2 * hstep;
    const unsigned ldsw = (unsigned)wid * 1024u;
    const int aoff = lds_byte(wr * 64 + fr, fq * 8), boff = lds_byte(wc * 32 + fr, fq * 8);
#define PG8_SA(b, h) (((b) * 2 + (h)) * HTB)
#define PG8_SB(b, h) ((4 + (b) * 2 + (h)) * HTB)
#define PG8_STAGE(bufoff, gbase, voff) do { _Pragma("unroll") for (int _i = 0; _i < 2; ++_i) \
        __builtin_amdgcn_global_load_lds((const unsigned*)((const char*)(gbase) + (voff)[_i]), (PG8_LAS unsigned*)(lds + (bufoff) + ldsw + _i * 8192), 16, 0, 0); } while (0)
#define PG8_LDA(dst, b, h) do { _Pragma("unroll") for (int m = 0; m < 4; ++m) _Pragma("unroll") for (int k = 0; k < 2; ++k) dst[m][k] = *(const PG8_LAS bf16x8*)(lds + PG8_SA(b, h) + aoff + m * 2048 + k * 1024); } while (0)
#define PG8_LDB(dst, b, h) do { _Pragma("unroll") for (int n = 0; n < 2; ++n) _Pragma("unroll") for (int k = 0; k < 2; ++k) dst[n][k] = *(const PG8_LAS bf16x8*)(lds + PG8_SB(b, h) + boff + n * 2048 + k * 1024); } while (0)
#define PG8_MMA(ai, bj, At, Bt) do { __builtin_amdgcn_s_setprio(1); _Pragma("unroll") for (int m = 0; m < 4; ++m) _Pragma("unroll") for (int n = 0; n < 2; ++n) _Pragma("unroll") for (int k = 0; k < 2; ++k) \
        acc[ai][bj][m][n] = __builtin_amdgcn_mfma_f32_16x16x32_bf16(Bt[n][k], At[m][k], acc[ai][bj][m][n], 0, 0, 0); __builtin_amdgcn_s_setprio(0); } while (0)
#define PG8_WAIT_V(n) asm volatile("s_waitcnt vmcnt(" #n ")" ::: "memory")
#define PG8_WAIT_L(n) asm volatile("s_waitcnt lgkmcnt(" #n ")" ::: "memory")
#define PG8_BAR __builtin_amdgcn_s_barrier()
#define PG8_SCHED __builtin_amdgcn_sched_barrier(0)
    Unit cur, nxt; int ui = 0;
    if (!S.next(0, cur)) return;
    f32x4 acc[2][2][4][2];
#pragma unroll
    for (int a = 0; a < 2; ++a)
#pragma unroll
        for (int b = 0; b < 2; ++b)
#pragma unroll
            for (int m = 0; m < 4; ++m)
#pragma unroll
                for (int n = 0; n < 2; ++n) acc[a][b][m][n] = (f32x4){0.f, 0.f, 0.f, 0.f};
    bf16x8 At[4][2], B0[2][2], B1[2][2];
    const char* cA = (const char*)g.A + (size_t)cur.pm * tstep; const char* cB = (const char*)g.Bt + (size_t)cur.pn * tstep;
    S.a_ready(cur);
    if constexpr (SP2) {
        PG8_STAGE(PG8_SB(0, 0), cB, voffB); PG8_STAGE(PG8_SB(0, 1), cB + hstep, voffB); PG8_STAGE(PG8_SA(0, 0), cA, voffA); PG8_STAGE(PG8_SA(0, 1), cA + hstep, voffA);
        if (wr == 1) PG8_BAR;
        PG8_WAIT_V(2); PG8_BAR;
        PG8_STAGE(PG8_SB(1, 0), cB + kstep, voffB); PG8_STAGE(PG8_SA(1, 0), cA + kstep, voffA); PG8_STAGE(PG8_SB(1, 1), cB + hstep + kstep, voffB);
        PG8_WAIT_V(6); PG8_BAR;
    } else {
        PG8_STAGE(PG8_SB(0, 0), cB, voffB); PG8_STAGE(PG8_SA(0, 0), cA, voffA); PG8_STAGE(PG8_SB(0, 1), cB + hstep, voffB); PG8_STAGE(PG8_SA(0, 1), cA + hstep, voffA);
        if (wr == 1) PG8_BAR;
        PG8_WAIT_V(4); PG8_BAR;
        PG8_STAGE(PG8_SB(1, 0), cB + kstep, voffB); PG8_STAGE(PG8_SA(1, 0), cA + kstep, voffA); PG8_STAGE(PG8_SB(1, 1), cB + hstep + kstep, voffB);
        PG8_WAIT_V(6); PG8_BAR;
    }
    for (;;) {
        const bool has_next = S.next(ui + 1, nxt);
        const char* nA = has_next ? (const char*)g.A + (size_t)nxt.pm * tstep : cA; const char* nB = has_next ? (const char*)g.Bt + (size_t)nxt.pn * tstep : cB;
        for (int t = 0; t < nt; t += 2) {
            const bool last = (t == nt - 2);
            const char* a1 = cA + (size_t)(t + 1) * kstep;
            const char* a2 = last ? nA : cA + (size_t)(t + 2) * kstep; const char* b2 = last ? nB : cB + (size_t)(t + 2) * kstep;
            const char* a3 = a2 + kstep; const char* b3 = b2 + kstep;
            if (last && has_next) S.a_ready(nxt);
            if constexpr (SP2) {
            PG8_LDB(B0, 0, 0); PG8_LDB(B1, 0, 1); PG8_SCHED; PG8_LDA(At, 0, 0); PG8_STAGE(PG8_SA(1, 1), a1 + hstep, voffA);
            PG8_WAIT_V(8); PG8_WAIT_L(0); PG8_BAR; PG8_MMA(0, 0, At, B0); PG8_MMA(0, 1, At, B1); PG8_BAR; PG8_SCHED;
            PG8_LDA(At, 0, 1); PG8_STAGE(PG8_SB(0, 0), b2, voffB); PG8_STAGE(PG8_SB(0, 1), b2 + hstep, voffB); PG8_STAGE(PG8_SA(0, 0), a2, voffA);
            PG8_WAIT_V(8); PG8_WAIT_L(0); PG8_BAR; PG8_MMA(1, 0, At, B0); PG8_MMA(1, 1, At, B1); PG8_BAR; PG8_SCHED;
            PG8_LDB(B0, 1, 0); PG8_LDB(B1, 1, 1); PG8_SCHED; PG8_LDA(At, 1, 0); PG8_STAGE(PG8_SA(0, 1), a2 + hstep, voffA);
            PG8_WAIT_V(8); PG8_WAIT_L(0); PG8_BAR; PG8_MMA(0, 0, At, B0); PG8_MMA(0, 1, At, B1); PG8_BAR; PG8_SCHED;
            PG8_LDA(At, 1, 1); PG8_STAGE(PG8_SB(1, 0), b3, voffB); PG8_STAGE(PG8_SB(1, 1), b3 + hstep, voffB); PG8_STAGE(PG8_SA(1, 0), a3, voffA);
            PG8_WAIT_V(8); PG8_WAIT_L(0); PG8_BAR; PG8_MMA(1, 0, At, B0); PG8_MMA(1, 1, At, B1); PG8_BAR; PG8_SCHED;
            } else {
            PG8_LDB(B0, 0, 0); PG8_SCHED; PG8_LDA(At, 0, 0); PG8_STAGE(PG8_SA(1, 1), a1 + hstep, voffA);
            PG8_WAIT_L(8); PG8_BAR; PG8_WAIT_L(0); PG8_MMA(0, 0, At, B0); PG8_BAR; PG8_SCHED;
            PG8_LDB(B1, 0, 1); PG8_STAGE(PG8_SB(0, 0), b2, voffB);
            PG8_BAR; PG8_WAIT_L(0); PG8_MMA(0, 1, At, B1); PG8_BAR;
            PG8_LDA(At, 0, 1); PG8_STAGE(PG8_SA(0, 0), a2, voffA);
            PG8_BAR; PG8_WAIT_L(0); PG8_MMA(1, 0, At, B0); PG8_BAR; PG8_SCHED;
            PG8_STAGE(PG8_SB(0, 1), b2 + hstep, voffB);
            PG8_WAIT_V(6); PG8_BAR; PG8_MMA(1, 1, At, B1); PG8_BAR;
            PG8_LDB(B0, 1, 0); PG8_SCHED; PG8_LDA(At, 1, 0); PG8_STAGE(PG8_SA(0, 1), a2 + hstep, voffA);
            PG8_WAIT_L(8); PG8_BAR; PG8_WAIT_L(0); PG8_MMA(0, 0, At, B0); PG8_BAR; PG8_SCHED;
            PG8_LDB(B1, 1, 1); PG8_STAGE(PG8_SB(1, 0), b3, voffB);
            PG8_BAR; PG8_WAIT_L(0); PG8_MMA(0, 1, At, B1); PG8_BAR;
            PG8_LDA(At, 1, 1); PG8_STAGE(PG8_SA(1, 0), a3, voffA);
            PG8_BAR; PG8_WAIT_L(0); PG8_MMA(1, 0, At, B0); PG8_BAR; PG8_SCHED;
            PG8_STAGE(PG8_SB(1, 1), b3 + hstep, voffB);
            PG8_WAIT_V(6); PG8_BAR; PG8_MMA(1, 1, At, B1); PG8_BAR;
            }
        }
        if constexpr (ALIGN_EPI) { if (wr == 0) PG8_BAR; }
        if constexpr (!Epi::AFTER_DRAIN) { E(acc, cur, wr, wc, fr, fq); S.done(cur); }
        if (!has_next) break;
#pragma unroll
        for (int a = 0; a < 2; ++a)
#pragma unroll
            for (int b = 0; b < 2; ++b)
#pragma unroll
                for (int m = 0; m < 4; ++m)
#pragma unroll
                    for (int n = 0; n < 2; ++n) acc[a][b][m][n] = (f32x4){0.f, 0.f, 0.f, 0.f};
        cur = nxt; cA = nA; cB = nB; ++ui;
        if constexpr (ALIGN_EPI) { if (wr == 1) PG8_BAR; }
    }
    PG8_WAIT_V(0);
    if constexpr (!ALIGN_EPI) { if (wr == 0) PG8_BAR; }
    PG8_BAR;
    if constexpr (Epi::AFTER_DRAIN) { E.fused(acc, cur, wr, wc, fr, fq, lds, wid, lane); S.done(cur); }
#undef PG8_SA
#undef PG8_SB
#undef PG8_STAGE
#undef PG8_LDA
#undef PG8_LDB
#undef PG8_MMA
#undef PG8_WAIT_V
#undef PG8_WAIT_L
#undef PG8_BAR
#undef PG8_SCHED
}
}

#define LAS __attribute__((address_space(3)))
typedef unsigned short bf16;
typedef unsigned v4u __attribute__((ext_vector_type(4)));
typedef unsigned v2u __attribute__((ext_vector_type(2)));
typedef float f32x4 __attribute__((ext_vector_type(4)));
typedef short bf16x8 __attribute__((ext_vector_type(8)));
constexpr int M = 16384, D = 1024, T = 4096, FF = 2816, NUP = 2 * FF, NIN0 = 1536, NHG = 4096;
constexpr float EPS = 1e-6f;
constexpr int NWAVES = 8, NTHR = 512;
constexpr int LDS_BYTES = 147456;
constexpr size_t MiB = 1u << 20;
constexpr size_t WS_WIN0 = 0, WS_WOUT0 = 3 * MiB, WS_PW = 5 * MiB, WS_UP0 = 5 * MiB + 512 * 1024, WS_DN0 = 16 * MiB + 512 * 1024, WS_HGIN = 22 * MiB;
constexpr size_t WS_HB = 30 * MiB;
constexpr size_t WS_Z = 64 * MiB;
constexpr size_t WS_AG = WS_Z, WS_UU = WS_Z + 16 * MiB, WS_CAT = WS_Z + 32 * MiB, WS_DD = WS_Z + 64 * MiB;
constexpr size_t WS_HID = WS_Z;
constexpr size_t WS_Q = WS_Z, WS_F = WS_Z + 32 * MiB, WS_V = WS_Z + 96 * MiB, WS_G = WS_Z + 128 * MiB;
constexpr size_t WS_U = 0;
constexpr size_t WS_HGOUT = 224 * MiB, WS_UP1 = 226 * MiB, WS_DN1 = 237 * MiB;
constexpr size_t WS_SS = 246 * MiB;
constexpr size_t WS_DEC = 244 * MiB;
constexpr size_t WS_CTL = 245 * MiB, CTL_ZERO_BYTES = 64 * 1024;
constexpr size_t WS_END = 251 * MiB;
constexpr int SSN = M * 16;
constexpr int LDSCTL_OFF = 131072, MISC_OFF = LDSCTL_OFF + 320;

__device__ __forceinline__ float wave_sum(float v) {
#pragma unroll
    for (int o = 1; o < 64; o <<= 1) v += __shfl_xor(v, o);
    return v;
}
typedef float f32x2_t __attribute__((ext_vector_type(2)));
typedef __bf16 bf16x2_t __attribute__((ext_vector_type(2)));
__device__ __forceinline__ unsigned pk2(float lo, float hi) { f32x2_t v = {lo, hi}; bf16x2_t b = __builtin_convertvector(v, bf16x2_t); return __builtin_bit_cast(unsigned, b); }
__device__ __forceinline__ float bflo(unsigned w) { return __uint_as_float(w << 16); }
__device__ __forceinline__ float bfhi(unsigned w) { return __uint_as_float(w & 0xffff0000u); }
__device__ __forceinline__ float sigmoidf_(float x) { return __builtin_amdgcn_rcpf(1.0f + __expf(-x)); }
#define LDS_WAIT() asm volatile("s_waitcnt lgkmcnt(0)" ::: "memory")
__device__ __forceinline__ float row_rstd(const float* ss, int row) {
    const f32x4* p = (const f32x4*)(ss + (size_t)row * 16);
    const f32x4 a = p[0], b = p[1], c = p[2], d = p[3];
    const float s = ((a[0] + a[1]) + (a[2] + a[3])) + ((b[0] + b[1]) + (b[2] + b[3])) + (((c[0] + c[1]) + (c[2] + c[3])) + ((d[0] + d[1]) + (d[2] + d[3])));
    return rsqrtf(s * (1.0f / D) + EPS);
}

using pg8::Unit;
typedef float accf4 __attribute__((ext_vector_type(4)));

struct EpiInCP {
    static constexpr bool PERM = true, AFTER_DRAIN = false;
    bf16* AG; bf16* UU; const float* ss;
    __device__ __forceinline__ void operator()(const accf4 (&acc)[2][2][4][2], const Unit& u, int wr, int wc, int fr, int fq) const {
        const int row0 = u.pm * 256 + wr * 64 + fr;
#pragma unroll
        for (int ai = 0; ai < 2; ++ai)
#pragma unroll
            for (int m = 0; m < 4; ++m) {
                const int row = row0 + ai * 128 + m * 16;
                const float rs = row_rstd(ss, row);
                if (u.pn < 4) {
                    float o[8];
#pragma unroll
                    for (int n = 0; n < 2; ++n)
#pragma unroll
                        for (int i = 0; i < 4; ++i) { const float v = acc[ai][0][m][n][i] * rs, g = acc[ai][1][m][n][i] * rs; o[4 * n + i] = v * sigmoidf_(g); }
                    v4u w; w.x = pk2(o[0], o[1]); w.y = pk2(o[2], o[3]); w.z = pk2(o[4], o[5]); w.w = pk2(o[6], o[7]);
                    *(v4u*)(AG + (size_t)row * 512 + 128 * u.pn + 32 * wc + 8 * fq) = w;
                } else {
#pragma unroll
                    for (int bj = 0; bj < 2; ++bj) {
                        const accf4 a0 = acc[ai][bj][m][0] * rs, a1 = acc[ai][bj][m][1] * rs;
                        v4u w; w.x = pk2(a0[0], a0[1]); w.y = pk2(a0[2], a0[3]); w.z = pk2(a1[0], a1[1]); w.w = pk2(a1[2], a1[3]);
                        *(v4u*)(UU + (size_t)row * 512 + 256 * (u.pn - 4) + 128 * bj + 32 * wc + 8 * fq) = w;
                    }
                }
            }
    }
};
struct EpiPool {
    static constexpr bool PERM = true, AFTER_DRAIN = false;
    bf16* CAT; const float* scale;
    __device__ __forceinline__ void operator()(const accf4 (&acc)[2][2][4][2], const Unit& u, int wr, int wc, int fr, int fq) const {
        const int row0 = u.pm * 256 + wr * 64 + fr;
#pragma unroll
        for (int bj = 0; bj < 2; ++bj) {
            const int col = 256 * u.pn + 128 * bj + 32 * wc + 8 * fq;
            const accf4 s0 = *(const accf4*)(scale + col), s1 = *(const accf4*)(scale + col + 4);
#pragma unroll
            for (int ai = 0; ai < 2; ++ai)
#pragma unroll
                for (int m = 0; m < 4; ++m) {
                    const int row = row0 + ai * 128 + m * 16;
                    const accf4 a0 = acc[ai][bj][m][0] * s0, a1 = acc[ai][bj][m][1] * s1;
                    v4u w; w.x = pk2(a0[0], a0[1]); w.y = pk2(a0[2], a0[3]); w.z = pk2(a1[0], a1[1]); w.w = pk2(a1[2], a1[3]);
                    *(v4u*)(CAT + (size_t)row * 1024 + 512 + col) = w;
                }
        }
    }
};
struct EpiResid {
    static constexpr bool PERM = true, AFTER_DRAIN = false;
    const bf16* hbi; bf16* hbo; float* outf; float* ssn;
    __device__ __forceinline__ void operator()(const accf4 (&acc)[2][2][4][2], const Unit& u, int wr, int wc, int fr, int fq) const {
        const int row0 = u.pm * 256 + wr * 64 + fr, colb = 256 * u.pn + 32 * wc + 8 * fq;
#pragma unroll
        for (int ai = 0; ai < 2; ++ai) {
            v4u rv[4][2];
#pragma unroll
            for (int m = 0; m < 4; ++m)
#pragma unroll
                for (int bj = 0; bj < 2; ++bj) rv[m][bj] = *(const v4u*)(hbi + (size_t)(row0 + ai * 128 + m * 16) * D + colb + 128 * bj);
#pragma unroll
            for (int m = 0; m < 4; ++m) {
                const int row = row0 + ai * 128 + m * 16;
                float p = 0.f;
#pragma unroll
                for (int bj = 0; bj < 2; ++bj) {
                    const size_t off = (size_t)row * D + colb + 128 * bj;
                    const v4u r = rv[m][bj];
                    accf4 o0, o1;
                    o0[0] = bflo(r.x) + acc[ai][bj][m][0][0]; o0[1] = bfhi(r.x) + acc[ai][bj][m][0][1]; o0[2] = bflo(r.y) + acc[ai][bj][m][0][2]; o0[3] = bfhi(r.y) + acc[ai][bj][m][0][3];
                    o1[0] = bflo(r.z) + acc[ai][bj][m][1][0]; o1[1] = bfhi(r.z) + acc[ai][bj][m][1][1]; o1[2] = bflo(r.w) + acc[ai][bj][m][1][2]; o1[3] = bfhi(r.w) + acc[ai][bj][m][1][3];
                    p += (o0[0] * o0[0] + o0[1] * o0[1]) + (o0[2] * o0[2] + o0[3] * o0[3]) + (o1[0] * o1[0] + o1[1] * o1[1]) + (o1[2] * o1[2] + o1[3] * o1[3]);
                    if (outf) { *(accf4*)(outf + off) = o0; *(accf4*)(outf + off + 4) = o1; }
                    else { v4u w; w.x = pk2(o0[0], o0[1]); w.y = pk2(o0[2], o0[3]); w.z = pk2(o1[0], o1[1]); w.w = pk2(o1[2], o1[3]); *(v4u*)(hbo + off) = w; }
                }
                p += __shfl_xor(p, 16); p += __shfl_xor(p, 32);
                if (fq == 0) ssn[(size_t)row * 16 + u.pn * 4 + wc] = p;
            }
        }
    }
};
struct EpiSwiGLU {
    static constexpr bool PERM = true, AFTER_DRAIN = false;
    bf16* HID; const float* ss;
    __device__ __forceinline__ void operator()(const accf4 (&acc)[2][2][4][2], const Unit& u, int wr, int wc, int fr, int fq) const {
        const int row0 = u.pm * 256 + wr * 64 + fr;
#pragma unroll
        for (int ai = 0; ai < 2; ++ai)
#pragma unroll
            for (int m = 0; m < 4; ++m) {
                const int row = row0 + ai * 128 + m * 16;
                const float rs = row_rstd(ss, row);
                float o[8];
#pragma unroll
                for (int n = 0; n < 2; ++n)
#pragma unroll
                    for (int i = 0; i < 4; ++i) { const float a = acc[ai][0][m][n][i] * rs, b = acc[ai][1][m][n][i] * rs; o[4 * n + i] = a * sigmoidf_(a) * b; }
                v4u w; w.x = pk2(o[0], o[1]); w.y = pk2(o[2], o[3]); w.z = pk2(o[4], o[5]); w.w = pk2(o[6], o[7]);
                *(v4u*)(HID + (size_t)row * FF + 128 * u.pn + 32 * wc + 8 * fq) = w;
            }
    }
};
struct EpiHgIn {
    static constexpr bool PERM = true, AFTER_DRAIN = false;
    bf16* Q; float* Fl; bf16* V; bf16* G; const float* ss; const float* lbl;
    __device__ __forceinline__ void operator()(const accf4 (&acc)[2][2][4][2], const Unit& u, int wr, int wc, int fr, int fq) const {
        const int row0 = u.pm * 256 + wr * 64 + fr, sec = u.pn >> 2, cb = 256 * (u.pn & 3) + 32 * wc + 8 * fq;
        if (sec == 1) {
#pragma unroll
            for (int bj = 0; bj < 2; ++bj) {
                const int col = cb + 128 * bj;
                float lb[8];
#pragma unroll
                for (int j = 0; j < 8; ++j) lb[j] = 1.0f / (1.0f + expf(lbl[col + j] - lbl[D + col + j]));
#pragma unroll
                for (int ai = 0; ai < 2; ++ai)
#pragma unroll
                    for (int m = 0; m < 4; ++m) {
                        const int row = row0 + ai * 128 + m * 16;
                        const float rs = row_rstd(ss, row);
                        accf4 o0, o1;
#pragma unroll
                        for (int i = 0; i < 4; ++i) {
                            const float z0 = acc[ai][bj][m][0][i] * rs, z1 = acc[ai][bj][m][1][i] * rs;
                            o0[i] = logf(lb[i] + (1.0f - lb[i]) * sigmoidf_(z0));
                            o1[i] = logf(lb[4 + i] + (1.0f - lb[4 + i]) * sigmoidf_(z1));
                        }
                        float* p = Fl + (size_t)row * D + col;
                        *(accf4*)p = o0; *(accf4*)(p + 4) = o1;
                    }
            }
        } else {
            bf16* O = Q + (sec ? (size_t)(sec + 1) * (16u << 20) : (size_t)0);
#pragma unroll
            for (int ai = 0; ai < 2; ++ai)
#pragma unroll
                for (int m = 0; m < 4; ++m) {
                    const int row = row0 + ai * 128 + m * 16;
                    const float rs = row_rstd(ss, row);
#pragma unroll
                    for (int bj = 0; bj < 2; ++bj) {
                        accf4 a0 = acc[ai][bj][m][0] * rs, a1 = acc[ai][bj][m][1] * rs;
                        if (sec == 3) {
#pragma unroll
                            for (int i = 0; i < 4; ++i) { a0[i] = a0[i] * sigmoidf_(a0[i]); a1[i] = a1[i] * sigmoidf_(a1[i]); }
                        }
                        v4u w; w.x = pk2(a0[0], a0[1]); w.y = pk2(a0[2], a0[3]); w.z = pk2(a1[0], a1[1]); w.w = pk2(a1[2], a1[3]);
                        *(v4u*)(O + (size_t)row * D + cb + 128 * bj) = w;
                    }
                }
        }
    }
};

#define XB_TMO      128
#define XB_XCNT(j)  (256  + 64 * (j))
#define XB_XSUB(j)  (1280 + 64 * (j))
#define XB_XGEN(j)  (2304 + 64 * (j))
#define XB_TOP      3328
#define XB_TOPGEN   3392
#define XCD_BAR_WORDS 3456
#define XB_SPIN_CAP (1u << 18)

__device__ __forceinline__ unsigned xb_ld(unsigned* p)              { return __hip_atomic_load(p, __ATOMIC_RELAXED, __HIP_MEMORY_SCOPE_AGENT); }
__device__ __forceinline__ unsigned xb_add(unsigned* p, unsigned v) { return __hip_atomic_fetch_add(p, v, __ATOMIC_RELAXED, __HIP_MEMORY_SCOPE_AGENT); }
__device__ __forceinline__ unsigned xb_xcc_id() { return (unsigned)__builtin_amdgcn_s_getreg((3 << 11) | 20) & 0xFu; }
#define XB_SPIN(cond, bar) do { unsigned _sp = 0; while (cond) { __builtin_amdgcn_s_sleep(1); \
    if ((++_sp & 255u) == 0u) { if (xb_ld(&(bar)[XB_TMO])) break; if (_sp > XB_SPIN_CAP) { atomicAdd(&(bar)[XB_TMO], 1u); break; } } } } while (0)

struct XcdBarrier {
    unsigned* bar; unsigned x;
    volatile LAS unsigned* st;
};

__device__ __forceinline__ XcdBarrier xcd_barrier_post(unsigned* bar, volatile LAS unsigned* st) {
    XcdBarrier b; b.bar = bar; b.x = xb_xcc_id(); b.st = st;
    if (threadIdx.x == 0) (void)xb_add(&bar[XB_XCNT(b.x)], 1u);
    return b;
}
__device__ __forceinline__ void xcd_barrier_complete(unsigned* bar, unsigned x, unsigned& nloc, unsigned& nx) {
    const unsigned G = gridDim.x * gridDim.y * gridDim.z;
    unsigned sum, cnt, mine, sp = 0u;
    for (;;) {
        sum = 0u; cnt = 0u; mine = 0u;
#pragma unroll
        for (unsigned j = 0; j < 16; ++j) { const unsigned c = xb_ld(&bar[XB_XCNT(j)]); sum += c; cnt += (c > 0u) ? 1u : 0u; mine = (j == x) ? c : mine; }
        if (sum == G) break;
        __builtin_amdgcn_s_sleep(1);
        if ((++sp & 255u) == 0u) { if (xb_ld(&bar[XB_TMO])) break; if (sp > XB_SPIN_CAP) { atomicAdd(&bar[XB_TMO], 1u); break; } }
    }
    nloc = mine > 0u ? mine : 1u; nx = cnt > 0u ? cnt : 1u;
}

__device__ __forceinline__ void xcd_barrier(const XcdBarrier& b) {
    asm volatile("s_waitcnt vmcnt(0)" ::: "memory");
    __syncthreads();
    if (threadIdx.x == 0) {
        unsigned* bar = b.bar;
        __builtin_amdgcn_s_waitcnt(0);
        unsigned nloc = b.st[0], nx = b.st[1];
        if (nloc == 0u) { xcd_barrier_complete(bar, b.x, nloc, nx); b.st[0] = nloc; b.st[1] = nx; }
        const unsigned old = xb_add(&bar[XB_XSUB(b.x)], 1u);
        const unsigned gen = old / nloc;
        if (old + 1u == (gen + 1u) * nloc) {
            __builtin_amdgcn_fence(__ATOMIC_RELEASE, "agent");
            asm volatile("s_waitcnt vmcnt(0)" ::: "memory");
            const unsigned og = xb_add(&bar[XB_TOP], 1u);
            const unsigned tg = og / nx;
            if (og + 1u == (tg + 1u) * nx) xb_add(&bar[XB_TOPGEN], 1u);
            else XB_SPIN(xb_ld(&bar[XB_TOPGEN]) == tg, bar);
            __builtin_amdgcn_fence(__ATOMIC_ACQUIRE, "agent");
            xb_add(&bar[XB_XGEN(b.x)], 1u);
            asm volatile("s_waitcnt vmcnt(0)" ::: "memory");
        } else {
            XB_SPIN(xb_ld(&bar[XB_XGEN(b.x)]) == gen, bar);
            __builtin_amdgcn_fence(__ATOMIC_ACQUIRE, "agent");
            asm volatile("s_waitcnt vmcnt(0)" ::: "memory");
        }
    }
    __syncthreads();
}
struct Args { const float* in[19]; float* out; unsigned char* ws; };
struct Frame {
    LAS unsigned char* lds;
    int tid, lane, wave, G, bid;
    const float* const* in; float* out; unsigned char* ws;
};

__device__ __forceinline__ void tr_item(const float* W, int N, int k0, int n0, bf16* dst, int ldk, const float* g, LAS float* scr, int lane) {
#pragma unroll 8
    for (int i = 0; i < 32; ++i) { const int kk = 2 * i + (lane >> 5); float w = W[(size_t)(k0 + kk) * N + n0 + (lane & 31)]; if (g) w *= g[k0 + kk]; scr[kk * 33 + (lane & 31)] = w; }
    LDS_WAIT(); asm volatile("" ::: "memory");
    const int c = lane & 7;
#pragma unroll
    for (int j = 0; j < 4; ++j) { const int n = (lane >> 3) + 8 * j; const LAS float* s = scr + (8 * c) * 33 + n;
        v4u o; o.x = pk2(s[0 * 33], s[1 * 33]); o.y = pk2(s[2 * 33], s[3 * 33]); o.z = pk2(s[4 * 33], s[5 * 33]); o.w = pk2(s[6 * 33], s[7 * 33]);
        *(v4u*)(dst + (size_t)n * ldk + 8 * c) = o; }
    LDS_WAIT(); asm volatile("" ::: "memory");
}
__device__ __forceinline__ int map_row(int type, int n0) {
    if (type == 0) return n0;
    if (type == 1) return 256 * (n0 >> 7) + (n0 & 127);
    if (type == 2) return 256 * (n0 >> 7) + 128 + (n0 & 127);
    if (n0 < 512) return 256 * (n0 >> 7) + (n0 & 127);
    if (n0 < 1024) return 256 * ((n0 - 512) >> 7) + 128 + (n0 & 127);
    return n0;
}
__device__ __forceinline__ void tr_job(const float* W, int K, int N, bf16* WT, const float* g, int type, int item, LAS float* scr, int lane) {
    const int nblk = N / 32, kb = item / nblk, nb = item % nblk, k0 = 64 * kb, n0 = 32 * nb;
    tr_item(W, N, k0, n0, WT + (size_t)map_row(type, n0) * K + k0, K, g, scr, lane);
}

__device__ __forceinline__ void p0_prologue(Frame& F) {
    LAS float* scr = (LAS float*)(F.lds + F.wave * 16384);
    const int gw = F.bid * NWAVES + F.wave, NGW = F.G * NWAVES;
    unsigned char* ws = F.ws;
    constexpr int I_IN0 = 16 * 48, I_SQ = 16 * 32, I_UP = 16 * 88, I_DN = 44 * 32, I_HG = 16 * 128;
    constexpr int NITEMS = I_IN0 + I_SQ + 2 * (2 * I_UP + I_DN) + I_HG + I_SQ;
    for (int it = gw; it < NITEMS; it += NGW) {
        int r = it;
        if (r < I_IN0) { tr_job(F.in[4], D, NIN0, (bf16*)(ws + WS_WIN0), F.in[1], 3, r, scr, F.lane); continue; } r -= I_IN0;
        if (r < I_SQ) { tr_job(F.in[11], D, D, (bf16*)(ws + WS_WOUT0), nullptr, 0, r, scr, F.lane); continue; } r -= I_SQ;
        if (r < I_UP) { tr_job(F.in[16], D, FF, (bf16*)(ws + WS_UP0), F.in[2], 1, r, scr, F.lane); continue; } r -= I_UP;
        if (r < I_UP) { tr_job(F.in[17], D, FF, (bf16*)(ws + WS_UP0), F.in[2], 2, r, scr, F.lane); continue; } r -= I_UP;
        if (r < I_DN) { tr_job(F.in[18], FF, D, (bf16*)(ws + WS_DN0), nullptr, 0, r, scr, F.lane); continue; } r -= I_DN;
        if (r < I_HG) { tr_job(F.in[12], D, NHG, (bf16*)(ws + WS_HGIN), F.in[1] + D, 0, r, scr, F.lane); continue; } r -= I_HG;
        if (r < I_SQ) { tr_job(F.in[15], D, D, (bf16*)(ws + WS_HGOUT), nullptr, 0, r, scr, F.lane); continue; } r -= I_SQ;
        if (r < I_UP) { tr_job(F.in[16] + (size_t)D * FF, D, FF, (bf16*)(ws + WS_UP1), F.in[2] + D, 1, r, scr, F.lane); continue; } r -= I_UP;
        if (r < I_UP) { tr_job(F.in[17] + (size_t)D * FF, D, FF, (bf16*)(ws + WS_UP1), F.in[2] + D, 2, r, scr, F.lane); continue; } r -= I_UP;
        tr_job(F.in[18] + (size_t)D * FF, FF, D, (bf16*)(ws + WS_DN1), nullptr, 0, r, scr, F.lane);
    }
    {
        const float* pw = F.in[9]; bf16* PW = (bf16*)(ws + WS_PW);
        for (int e = F.bid * NTHR + F.tid; e < 512 * 512; e += F.G * NTHR) {
            const int n = e >> 9, k = e & 511, g = n >> 7;
            float v = 0.f; if ((k >> 7) == g) v = pw[g * 16384 + (k & 127) * 128 + (n & 127)];
            PW[e] = (bf16)(pk2(v, 0.f) & 0xffffu);
        }
    }
    float* ss = (float*)(ws + WS_SS);
    const float* x = F.in[0]; bf16* HB = (bf16*)F.out;
    for (int m = gw; m < M; m += NGW) {
        const f32x4* xr = (const f32x4*)(x + (size_t)m * D) + F.lane;
        f32x4 v[4]; float s = 0.f;
#pragma unroll
        for (int j = 0; j < 4; ++j) { v[j] = xr[64 * j]; s += (v[j][0] * v[j][0] + v[j][1] * v[j][1]) + (v[j][2] * v[j][2] + v[j][3] * v[j][3]); }
        s = wave_sum(s);
        if (F.lane < 16) ss[(size_t)m * 16 + F.lane] = F.lane == 0 ? s : 0.f;
        v2u* o8 = (v2u*)(HB + (size_t)m * D) + F.lane;
#pragma unroll
        for (int j = 0; j < 4; ++j) { v2u w; w.x = pk2(v[j][0], v[j][1]); w.y = pk2(v[j][2], v[j][3]); o8[64 * j] = w; }
    }
}

__device__ __forceinline__ void phase_convpool(Frame& F) {
    LAS float* wl = (LAS float*)F.lds;
    LAS unsigned char* at = F.lds + 63488;
    const float* dw_w = F.in[5]; const float* dw_b = F.in[6]; const float* ln_g = F.in[7]; const float* ln_b = F.in[8];
    const bf16* AG = (const bf16*)(F.ws + WS_AG); const bf16* UU = (const bf16*)(F.ws + WS_UU);
    bf16* CAT = (bf16*)(F.ws + WS_CAT); bf16* DD = (bf16*)(F.ws + WS_DD);
    const int tid = F.tid, lane = F.lane, w = F.wave;
    for (int e = tid; e < 31 * 128; e += NTHR) { const int j = e >> 7, q4 = e & 127;
        const f32x4 v = *(const f32x4*)(dw_w + j * 512 + 4 * q4);
        *(LAS f32x4*)(wl + ((j * 2 + (q4 & 1)) * 64 + (q4 >> 1)) * 4) = v; }
    const int PW_ = 2 << (lane >> 4);
    for (int tile = F.bid; tile < M / 32; tile += F.G) {
        const int m0 = tile * 32, tpos0 = m0 & (T - 1);
        __syncthreads();
        for (int e = tid; e < 64 * 64; e += NTHR) { const int rr = e >> 6, ch = e & 63; v4u v = (v4u){0u, 0u, 0u, 0u};
            if (tpos0 - 30 + rr >= 0 && rr < 62) v = *(const v4u*)(AG + (size_t)(m0 - 30 + rr) * 512 + ch * 8);
            *(LAS v4u*)(at + rr * 1024 + ch * 16) = v; }
        __syncthreads();
        float acc[4][8];
        {
            const f32x4 b0 = *(const f32x4*)(dw_b + lane * 8), b1 = *(const f32x4*)(dw_b + lane * 8 + 4);
#pragma unroll
            for (int tt = 0; tt < 4; ++tt)
#pragma unroll
                for (int i = 0; i < 4; ++i) { acc[tt][i] = b0[i]; acc[tt][4 + i] = b1[i]; }
        }
        float wreg[4][8];
#pragma unroll
        for (int rr = 0; rr < 4; ++rr)
#pragma unroll
            for (int i = 0; i < 8; ++i) wreg[rr][i] = 0.f;
#pragma unroll 1
        for (int rb = 0; rb < 9; ++rb) {
#pragma unroll
            for (int rr = 0; rr < 4; ++rr) {
                const int r = 4 * rb + rr;
                const v4u av = *(const LAS v4u*)(at + (4 * w + r) * 1024 + lane * 16);
                float a[8]; a[0] = bflo(av.x); a[1] = bfhi(av.x); a[2] = bflo(av.y); a[3] = bfhi(av.y); a[4] = bflo(av.z); a[5] = bfhi(av.z); a[6] = bflo(av.w); a[7] = bfhi(av.w);
                f32x4 w0 = (f32x4){0.f, 0.f, 0.f, 0.f}, w1 = w0;
                if (r <= 30) { w0 = *(const LAS f32x4*)(wl + ((r * 2 + 0) * 64 + lane) * 4); w1 = *(const LAS f32x4*)(wl + ((r * 2 + 1) * 64 + lane) * 4); }
#pragma unroll
                for (int i = 0; i < 4; ++i) { wreg[rr][i] = w0[i]; wreg[rr][4 + i] = w1[i]; }
#pragma unroll
                for (int tt = 0; tt < 4; ++tt) {
#pragma unroll
                    for (int i = 0; i < 8; ++i) acc[tt][i] += wreg[(rr - tt) & 3][i] * a[i]; }
            }
        }
        float lg[8], lb[8];
        {
            const f32x4 g0 = *(const f32x4*)(ln_g + lane * 8), g1 = *(const f32x4*)(ln_g + lane * 8 + 4), c0 = *(const f32x4*)(ln_b + lane * 8), c1 = *(const f32x4*)(ln_b + lane * 8 + 4);
#pragma unroll
            for (int i = 0; i < 4; ++i) { lg[i] = g0[i]; lg[4 + i] = g1[i]; lb[i] = c0[i]; lb[4 + i] = c1[i]; }
        }
#pragma unroll
        for (int tt = 0; tt < 4; ++tt) {
            float s = 0.f;
#pragma unroll
            for (int i = 0; i < 8; ++i) s += acc[tt][i];
            const float mean = wave_sum(s) * (1.0f / 512.0f);
            float q = 0.f;
#pragma unroll
            for (int i = 0; i < 8; ++i) { acc[tt][i] -= mean; q += acc[tt][i] * acc[tt][i]; }
            const float rstd = rsqrtf(wave_sum(q) * (1.0f / 512.0f) + EPS);
            float o[8];
#pragma unroll
            for (int i = 0; i < 8; ++i) { const float y = acc[tt][i] * rstd * lg[i] + lb[i]; o[i] = y * sigmoidf_(y); }
            v4u wv; wv.x = pk2(o[0], o[1]); wv.y = pk2(o[2], o[3]); wv.z = pk2(o[4], o[5]); wv.w = pk2(o[6], o[7]);
            *(v4u*)(CAT + (size_t)(m0 + 4 * w + tt) * 1024 + lane * 8) = wv;
        }
        {
            const int mb = m0 + 4 * w, tb = tpos0 + 4 * w;
            float sum[4][8], self[4][8];
#pragma unroll
            for (int tt = 0; tt < 4; ++tt)
#pragma unroll
                for (int i = 0; i < 8; ++i) { sum[tt][i] = 0.f; self[tt][i] = 0.f; }
#pragma unroll
            for (int r = 0; r < 19; ++r) {
                if (tb - 15 + r < 0) continue;
                const v4u uv = *(const v4u*)(UU + (size_t)(mb - 15 + r) * 512 + lane * 8);
                float a[8]; a[0] = bflo(uv.x); a[1] = bfhi(uv.x); a[2] = bflo(uv.y); a[3] = bfhi(uv.y); a[4] = bflo(uv.z); a[5] = bfhi(uv.z); a[6] = bflo(uv.w); a[7] = bfhi(uv.w);
#pragma unroll
                for (int tt = 0; tt < 4; ++tt) { const int i_ = 15 + tt - r; if (i_ >= 0 && i_ < 16) {
                    const bool in = i_ < PW_;
#pragma unroll
                    for (int i = 0; i < 8; ++i) { sum[tt][i] += in ? a[i] : 0.f; if (i_ == 0) self[tt][i] = a[i]; } } }
            }
#pragma unroll
            for (int tt = 0; tt < 4; ++tt) {
                const int tp = tb + tt; const int cnt = (tp + 1) < PW_ ? (tp + 1) : PW_;
                const float inv = 1.0f / (float)cnt;
                float o[8];
#pragma unroll
                for (int i = 0; i < 8; ++i) o[i] = sum[tt][i] * inv - self[tt][i];
                v4u wv; wv.x = pk2(o[0], o[1]); wv.y = pk2(o[2], o[3]); wv.z = pk2(o[4], o[5]); wv.w = pk2(o[6], o[7]);
                *(v4u*)(DD + (size_t)(mb + tt) * 512 + lane * 8) = wv;
            }
        }
    }
    __syncthreads();
}

constexpr int KT_P = 72;
constexpr int QS_P = 136;
__device__ __forceinline__ void phase_hg_state(Frame& F) {
    LAS float* Bf = (LAS float*)F.lds;
    LAS float* tot = (LAS float*)(F.lds + 32768);
    LAS bf16* KT = (LAS bf16*)(F.lds + 34816);
    LAS bf16* VT = (LAS bf16*)(F.lds + 34816 + 128 * KT_P * 2);
    const float* Fl = (const float*)(F.ws + WS_F); const bf16* V = (const bf16*)(F.ws + WS_V);
    bf16* U = (bf16*)(F.ws + WS_U); float* DEC = (float*)(F.ws + WS_DEC);
    const int tid = F.tid, lane = F.lane, w = F.wave, c = tid & 127, qd = tid >> 7, l16 = lane & 15, lq = lane >> 4;
    for (int unit = F.bid; unit < 2048; unit += F.G) {
        const int bh = unit >> 6, chunk = unit & 63, b = bh >> 3, h = bh & 7;
        const size_t m0 = (size_t)b * T + chunk * 64; const int c0 = h * 128;
        __syncthreads();
        for (int e = tid; e < 2048; e += NTHR) { const int s = e >> 5, c4 = e & 31;
            *(LAS f32x4*)(Bf + s * 128 + c4 * 4) = *(const f32x4*)(Fl + (m0 + s) * D + c0 + c4 * 4); }
        unsigned vv[8];
#pragma unroll
        for (int i = 0; i < 8; ++i) { const unsigned lo = V[(m0 + 16 * qd + 2 * i) * D + c0 + c], hi = V[(m0 + 16 * qd + 2 * i + 1) * D + c0 + c]; vv[i] = lo | (hi << 16); }
        __syncthreads();
        float lf[16], bs[16]; float run = 0.f;
#pragma unroll
        for (int i = 0; i < 16; ++i) { lf[i] = Bf[(16 * qd + i) * 128 + c]; run += lf[i]; bs[i] = run; }
        tot[qd * 128 + c] = run;
        __syncthreads();
        float pre = 0.f, total = 0.f;
#pragma unroll
        for (int q = 0; q < 4; ++q) { const float t = tot[q * 128 + c]; total += t; if (q < qd) pre += t; }
        unsigned kk[8];
#pragma unroll
        for (int i = 0; i < 8; ++i) {
            const float b0 = bs[2 * i] + pre, b1 = bs[2 * i + 1] + pre;
            const float k0 = (1.0f - __expf(lf[2 * i])) * __expf(total - b0), k1 = (1.0f - __expf(lf[2 * i + 1])) * __expf(total - b1);
            kk[i] = pk2(k0, k1);
        }
        *(LAS v4u*)(KT + c * KT_P + 16 * qd) = (v4u){kk[0], kk[1], kk[2], kk[3]};
        *(LAS v4u*)(KT + c * KT_P + 16 * qd + 8) = (v4u){kk[4], kk[5], kk[6], kk[7]};
        *(LAS v4u*)(VT + c * KT_P + 16 * qd) = (v4u){vv[0], vv[1], vv[2], vv[3]};
        *(LAS v4u*)(VT + c * KT_P + 16 * qd + 8) = (v4u){vv[4], vv[5], vv[6], vv[7]};
        if (qd == 3) DEC[(size_t)unit * 128 + c] = __expf(total);
        __syncthreads();
        const bf16x8 a0 = *(const LAS bf16x8*)(KT + (16 * w + l16) * KT_P + 8 * lq), a1 = *(const LAS bf16x8*)(KT + (16 * w + l16) * KT_P + 8 * lq + 32);
#pragma unroll
        for (int vb = 0; vb < 8; ++vb) {
            const bf16x8 b0 = *(const LAS bf16x8*)(VT + (16 * vb + l16) * KT_P + 8 * lq), b1 = *(const LAS bf16x8*)(VT + (16 * vb + l16) * KT_P + 8 * lq + 32);
            f32x4 acc = (f32x4){0.f, 0.f, 0.f, 0.f};
            acc = __builtin_amdgcn_mfma_f32_16x16x32_bf16(a0, b0, acc, 0, 0, 0);
            acc = __builtin_amdgcn_mfma_f32_16x16x32_bf16(a1, b1, acc, 0, 0, 0);
            v2u o; o.x = pk2(acc[0], acc[1]); o.y = pk2(acc[2], acc[3]);
            *(v2u*)(U + ((size_t)unit * 128 + 16 * vb + l16) * 128 + 16 * w + 4 * lq) = o;
        }
    }
    __syncthreads();
}
__device__ __forceinline__ void phase_hg_scan(Frame& F) {
    bf16* U = (bf16*)(F.ws + WS_U); const float* DEC = (const float*)(F.ws + WS_DEC);
    for (int it = F.bid * NTHR + F.tid; it < 32 * 128 * 32; it += F.G * NTHR) {
        const int bh = it >> 12, v = (it >> 5) & 127, k4 = (it & 31) * 4;
        bf16* up = U + ((size_t)(bh * 64) * 128 + v) * 128 + k4;
        const float* dp = DEC + (size_t)(bh * 64) * 128 + k4;
        float S0 = 0.f, S1 = 0.f, S2 = 0.f, S3 = 0.f;
        for (int cb = 0; cb < 64; cb += 8) {
            v2u uu[8]; f32x4 dd[8];
#pragma unroll
            for (int j = 0; j < 8; ++j) { uu[j] = *(const v2u*)(up + (size_t)(cb + j) * 16384); dd[j] = *(const f32x4*)(dp + (cb + j) * 128); }
#pragma unroll
            for (int j = 0; j < 8; ++j) {
                v2u o; o.x = pk2(S0, S1); o.y = pk2(S2, S3);
                *(v2u*)(up + (size_t)(cb + j) * 16384) = o;
                S0 = dd[j][0] * S0 + bflo(uu[j].x); S1 = dd[j][1] * S1 + bfhi(uu[j].x); S2 = dd[j][2] * S2 + bflo(uu[j].y); S3 = dd[j][3] * S3 + bfhi(uu[j].y);
            }
        }
    }
}
__device__ __forceinline__ void phase_hg_out(Frame& F) {
    LAS float* Bf = (LAS float*)F.lds;
    LAS float* tot = (LAS float*)(F.lds + 32768);
    LAS bf16* Qs = (LAS bf16*)(F.lds + 34816);
    LAS bf16* Ks = (LAS bf16*)(F.lds + 52224);
    LAS bf16* VT = (LAS bf16*)(F.lds + 69632);
    LAS bf16* Sc = (LAS bf16*)(F.lds + 88064);
    LAS float* part = (LAS float*)(F.lds + 97280);
    const float* Fl = (const float*)(F.ws + WS_F); const bf16* V = (const bf16*)(F.ws + WS_V); const bf16* G = (const bf16*)(F.ws + WS_G);
    bf16* Q = (bf16*)(F.ws + WS_Q); const bf16* U = (const bf16*)(F.ws + WS_U); const float* gn = F.in[14];
    const int tid = F.tid, lane = F.lane, w = F.wave, c = tid & 127, qd = tid >> 7, l16 = lane & 15, lq = lane >> 4;
    for (int unit = F.bid; unit < 2048; unit += F.G) {
        const int bh = unit >> 6, chunk = unit & 63, b = bh >> 3, h = bh & 7;
        const size_t m0 = (size_t)b * T + chunk * 64; const int c0 = h * 128;
        __syncthreads();
        for (int e = tid; e < 2048; e += NTHR) { const int s = e >> 5, c4 = e & 31;
            *(LAS f32x4*)(Bf + s * 128 + c4 * 4) = *(const f32x4*)(Fl + (m0 + s) * D + c0 + c4 * 4); }
        unsigned vv[8], qq[8];
#pragma unroll
        for (int i = 0; i < 8; ++i) {
            const size_t o0 = (m0 + 16 * qd + 2 * i) * D + c0 + c, o1 = o0 + D;
            vv[i] = (unsigned)V[o0] | ((unsigned)V[o1] << 16); qq[i] = (unsigned)Q[o0] | ((unsigned)Q[o1] << 16);
        }
        bf16x8 st[4];
#pragma unroll
        for (int kk = 0; kk < 4; ++kk) st[kk] = *(const bf16x8*)(U + ((size_t)unit * 128 + 16 * w + l16) * 128 + 8 * lq + 32 * kk);
        __syncthreads();
        float lf[16], bs[16]; float run = 0.f;
#pragma unroll
        for (int i = 0; i < 16; ++i) { lf[i] = Bf[(16 * qd + i) * 128 + c]; run += lf[i]; bs[i] = run; }
        tot[qd * 128 + c] = run;
        __syncthreads();
        float pre = 0.f;
#pragma unroll
        for (int q = 0; q < 4; ++q) { const float t = tot[q * 128 + c]; if (q < qd) pre += t; }
#pragma unroll
        for (int i = 0; i < 16; ++i) {
            const float bb = bs[i] + pre;
            const float qv = ((i & 1) ? bfhi(qq[i >> 1]) : bflo(qq[i >> 1])) * __expf(bb);
            const float kv = (1.0f - __expf(lf[i])) * __expf(-bb);
            const unsigned pq = pk2(qv, kv);
            Qs[(16 * qd + i) * QS_P + c] = (bf16)(pq & 0xffffu);
            Ks[(16 * qd + i) * QS_P + c] = (bf16)(pq >> 16);
        }
        *(LAS v4u*)(VT + c * KT_P + 16 * qd) = (v4u){vv[0], vv[1], vv[2], vv[3]};
        *(LAS v4u*)(VT + c * KT_P + 16 * qd + 8) = (v4u){vv[4], vv[5], vv[6], vv[7]};
        __syncthreads();
        {
            const int tb = w >> 1;
            bf16x8 qf[4];
#pragma unroll
            for (int kk = 0; kk < 4; ++kk) qf[kk] = *(const LAS bf16x8*)(Qs + (16 * tb + l16) * QS_P + 8 * lq + 32 * kk);
#pragma unroll
            for (int j = 0; j < 2; ++j) {
                const int sb = 2 * (w & 1) + j;
                f32x4 acc = (f32x4){0.f, 0.f, 0.f, 0.f};
                if (sb <= tb) {
#pragma unroll
                    for (int kk = 0; kk < 4; ++kk) { const bf16x8 kf = *(const LAS bf16x8*)(Ks + (16 * sb + l16) * QS_P + 8 * lq + 32 * kk);
                        acc = __builtin_amdgcn_mfma_f32_16x16x32_bf16(kf, qf[kk], acc, 0, 0, 0); }
                    const int t = 16 * tb + l16, s0 = 16 * sb + 4 * lq;
#pragma unroll
                    for (int i = 0; i < 4; ++i) if (s0 + i > t) acc[i] = 0.f;
                }
                v2u o; o.x = pk2(acc[0], acc[1]); o.y = pk2(acc[2], acc[3]);
                *(LAS v2u*)(Sc + (16 * tb + l16) * KT_P + 16 * sb + 4 * lq) = o;
            }
        }
        __syncthreads();
        f32x4 oacc[4];
        {
            const bf16x8 vf0 = *(const LAS bf16x8*)(VT + (16 * w + l16) * KT_P + 8 * lq), vf1 = *(const LAS bf16x8*)(VT + (16 * w + l16) * KT_P + 8 * lq + 32);
#pragma unroll
            for (int tb = 0; tb < 4; ++tb) {
                f32x4 acc = (f32x4){0.f, 0.f, 0.f, 0.f};
#pragma unroll
                for (int kk = 0; kk < 4; ++kk) { const bf16x8 qf = *(const LAS bf16x8*)(Qs + (16 * tb + l16) * QS_P + 8 * lq + 32 * kk);
                    acc = __builtin_amdgcn_mfma_f32_16x16x32_bf16(st[kk], qf, acc, 0, 0, 0); }
                const bf16x8 s0 = *(const LAS bf16x8*)(Sc + (16 * tb + l16) * KT_P + 8 * lq), s1 = *(const LAS bf16x8*)(Sc + (16 * tb + l16) * KT_P + 8 * lq + 32);
                acc = __builtin_amdgcn_mfma_f32_16x16x32_bf16(vf0, s0, acc, 0, 0, 0);
                acc = __builtin_amdgcn_mfma_f32_16x16x32_bf16(vf1, s1, acc, 0, 0, 0);
                oacc[tb] = acc;
                float p = (acc[0] * acc[0] + acc[1] * acc[1]) + (acc[2] * acc[2] + acc[3] * acc[3]);
                p += __shfl_xor(p, 16); p += __shfl_xor(p, 32);
                if (lane < 16) part[w * 64 + 16 * tb + lane] = p;
            }
        }
        __syncthreads();
        {
            const f32x4 gv = *(const f32x4*)(gn + c0 + 16 * w + 4 * lq);
#pragma unroll
            for (int tb = 0; tb < 4; ++tb) {
                const int t = 16 * tb + l16;
                float s = 0.f;
#pragma unroll
                for (int ww = 0; ww < 8; ++ww) s += part[ww * 64 + t];
                const float rstd = rsqrtf(s * (1.0f / 128.0f) + EPS);
                const size_t off = (m0 + t) * D + c0 + 16 * w + 4 * lq;
                const v2u gg = *(const v2u*)(G + off);
                v2u o; o.x = pk2(oacc[tb][0] * rstd * gv[0] * bflo(gg.x), oacc[tb][1] * rstd * gv[1] * bfhi(gg.x));
                o.y = pk2(oacc[tb][2] * rstd * gv[2] * bflo(gg.y), oacc[tb][3] * rstd * gv[3] * bfhi(gg.y));
                *(v2u*)(Q + off) = o;
            }
        }
    }
    __syncthreads();
}
__device__ __forceinline__ void phase_final(Frame& F) {
    const float* ss = (const float*)(F.ws + WS_SS) + 4 * SSN; const float* fg = F.in[3];
    const int gw = F.bid * NWAVES + F.wave, NGW = F.G * NWAVES;
    f32x4 g[4];
#pragma unroll
    for (int j = 0; j < 4; ++j) g[j] = *((const f32x4*)fg + F.lane + 64 * j);
    for (int m = gw; m < M; m += NGW) {
        const float rs = row_rstd(ss, m);
        f32x4* xr = (f32x4*)(F.out + (size_t)m * D) + F.lane;
#pragma unroll
        for (int j = 0; j < 4; ++j) { f32x4 v = xr[64 * j]; v = v * rs * g[j]; xr[64 * j] = v; }
    }
}


#ifdef STOP_AFTER
__device__ __forceinline__ void dbg_dump(Frame& F, int k) {
    unsigned char* ws = F.ws;
    for (size_t i = (size_t)F.bid * NTHR + F.tid; i < (size_t)M * D; i += (size_t)F.G * NTHR) {
        const size_t m = i >> 10; const int c = (int)(i & 1023);
        float v = 0.f;
        if (k == 0) v = __uint_as_float((unsigned)((const bf16*)(ws + WS_HB))[i] << 16) + ((const float*)(ws + WS_SS))[m] * 1e-3f + __uint_as_float((unsigned)((const bf16*)(ws + WS_UP1))[i] << 16) + __uint_as_float((unsigned)((const bf16*)(ws + WS_HGIN))[i] << 16);
        else if (k == 1) v = c < 512 ? __uint_as_float((unsigned)((const bf16*)(ws + WS_AG))[m * 512 + c] << 16) : __uint_as_float((unsigned)((const bf16*)(ws + WS_UU))[m * 512 + c - 512] << 16);
        else if (k == 2) v = c < 512 ? __uint_as_float((unsigned)((const bf16*)(ws + WS_CAT))[m * 1024 + c] << 16) : __uint_as_float((unsigned)((const bf16*)(ws + WS_DD))[m * 512 + c - 512] << 16);
        else if (k == 3) v = __uint_as_float((unsigned)((const bf16*)(ws + WS_CAT))[i] << 16);
        else if (k == 4) v = F.out[i] + __uint_as_float((unsigned)((const bf16*)(ws + WS_HB))[i] << 16) + ((const float*)(ws + WS_SS))[M + m] * 1e-3f;
        else if (k == 5) v = __uint_as_float((unsigned)((const bf16*)(ws + WS_HID))[m * FF + c] << 16) + __uint_as_float((unsigned)((const bf16*)(ws + WS_HID))[m * FF + 1024 + c] << 16) + __uint_as_float((unsigned)((const bf16*)(ws + WS_HID))[m * FF + 1792 + c] << 16);
        else if (k == 6) v = F.out[i];
        else if (k == 7) v = __uint_as_float((unsigned)((const bf16*)(ws + WS_Q))[i] << 16) + ((const float*)(ws + WS_F))[i] + __uint_as_float((unsigned)((const bf16*)(ws + WS_V))[i] << 16) + __uint_as_float((unsigned)((const bf16*)(ws + WS_G))[i] << 16);
        else if (k == 8 || k == 9) v = __uint_as_float((unsigned)((const bf16*)(ws + WS_U))[i] << 16) + __uint_as_float((unsigned)((const bf16*)(ws + WS_U))[i + (size_t)M * D] << 16) + ((const float*)(ws + WS_DEC))[i & 262143];
        else if (k == 10) v = __uint_as_float((unsigned)((const bf16*)(ws + WS_Q))[i] << 16);
        else v = F.out[i];
        F.out[i] = v;
    }
}
#define DBG_STOP(k) do { if (STOP_AFTER == (k)) { if ((k) == 4 || (k) == 6 || (k) >= 11) {   } dbg_dump(F, (k)); return; } } while (0)
#else
#define DBG_STOP(k) do { } while (0)
#endif
#define GEMM_PHASE(EPI, Aptr, Bptr, NN, KK, E) do { pg8::Gemm g_{(const pg8::bf16_t*)(Aptr), (const pg8::bf16_t*)(Bptr), M, (NN), (KK)}; pg8::StaticOrder S_; S_.init(M, (NN), F.G, F.bid); \
        pg8::gemm_phase<EPI, pg8::StaticOrder, true, true>(F.lds, g_, S_, (E)); } while (0)

__global__ void __launch_bounds__(NTHR, 2) trunk_fwd(Args args) {
    extern __shared__ __attribute__((aligned(16))) unsigned char lds_raw[];
    Frame F;
    F.lds = (LAS unsigned char*)lds_raw;
    F.tid = threadIdx.x; F.lane = F.tid & 63; F.wave = __builtin_amdgcn_readfirstlane(F.tid >> 6);
    F.G = gridDim.x; F.bid = blockIdx.x;
    F.in = args.in; F.out = args.out; F.ws = args.ws;
    unsigned char* ws = args.ws;
    float* ss = (float*)(ws + WS_SS);
    bf16* HB = (bf16*)args.out;
    bf16* HB1 = (bf16*)(ws + WS_HB);

    for (int u = F.tid; u < (LDS_BYTES - LDSCTL_OFF) / 4; u += NTHR) ((LAS unsigned*)(F.lds + LDSCTL_OFF))[u] = 0u;
    __syncthreads();
    XcdBarrier bar = xcd_barrier_post((unsigned*)(ws + WS_CTL), (volatile LAS unsigned*)(F.lds + MISC_OFF) + 8);
    cg::this_grid().sync();
#define GRID_SYNC() xcd_barrier(bar)
#if !defined(PHMASK) || (PHMASK & (1 << 0))
    p0_prologue(F);
#endif
    GRID_SYNC();
    DBG_STOP(0);
#if !defined(PHMASK) || (PHMASK & (1 << 1))
    { EpiInCP E{(bf16*)(ws + WS_AG), (bf16*)(ws + WS_UU), ss}; GEMM_PHASE(EpiInCP, HB, ws + WS_WIN0, NIN0, D, E); }
#endif
    GRID_SYNC();
    DBG_STOP(1);
#if !defined(PHMASK) || (PHMASK & (1 << 2))
    phase_convpool(F);
#endif
    GRID_SYNC();
    DBG_STOP(2);
#if !defined(PHMASK) || (PHMASK & (1 << 3))
    { EpiPool E{(bf16*)(ws + WS_CAT), F.in[10]}; GEMM_PHASE(EpiPool, ws + WS_DD, ws + WS_PW, 512, 512, E); }
#endif
    GRID_SYNC();
    DBG_STOP(3);
#if !defined(PHMASK) || (PHMASK & (1 << 4))
    { EpiResid E{HB, HB, nullptr, ss + SSN}; GEMM_PHASE(EpiResid, ws + WS_CAT, ws + WS_WOUT0, D, D, E); }
#endif
    GRID_SYNC();
    DBG_STOP(4);
#if !defined(PHMASK) || (PHMASK & (1 << 5))
    { EpiSwiGLU E{(bf16*)(ws + WS_HID), ss + SSN}; GEMM_PHASE(EpiSwiGLU, HB, ws + WS_UP0, NUP, D, E); }
#endif
    GRID_SYNC();
    DBG_STOP(5);
#if !defined(PHMASK) || (PHMASK & (1 << 6))
    { EpiResid E{HB, HB, nullptr, ss + 2 * SSN}; GEMM_PHASE(EpiResid, ws + WS_HID, ws + WS_DN0, D, FF, E); }
#endif
    GRID_SYNC();
    DBG_STOP(6);
#if !defined(PHMASK) || (PHMASK & (1 << 7))
    { EpiHgIn E{(bf16*)(ws + WS_Q), (float*)(ws + WS_F), (bf16*)(ws + WS_V), (bf16*)(ws + WS_G), ss + 2 * SSN, F.in[13]}; GEMM_PHASE(EpiHgIn, HB, ws + WS_HGIN, NHG, D, E); }
#endif
    GRID_SYNC();
    DBG_STOP(7);
#if !defined(PHMASK) || (PHMASK & (1 << 8))
    phase_hg_state(F);
#endif
    GRID_SYNC();
    DBG_STOP(8);
#if !defined(PHMASK) || (PHMASK & (1 << 9))
    phase_hg_scan(F);
#endif
    GRID_SYNC();
    DBG_STOP(9);
#if !defined(PHMASK) || (PHMASK & (1 << 10))
    phase_hg_out(F);
#endif
    GRID_SYNC();
    DBG_STOP(10);
#if !defined(PHMASK) || (PHMASK & (1 << 11))
    { EpiResid E{HB, HB1, nullptr, ss + 3 * SSN}; GEMM_PHASE(EpiResid, ws + WS_Q, ws + WS_HGOUT, D, D, E); }
#endif
    GRID_SYNC();
    DBG_STOP(11);
#if !defined(PHMASK) || (PHMASK & (1 << 12))
    { EpiSwiGLU E{(bf16*)(ws + WS_HID), ss + 3 * SSN}; GEMM_PHASE(EpiSwiGLU, HB1, ws + WS_UP1, NUP, D, E); }
#endif
    GRID_SYNC();
    DBG_STOP(12);
#if !defined(PHMASK) || (PHMASK & (1 << 13))
    { EpiResid E{HB1, nullptr, F.out, ss + 4 * SSN}; GEMM_PHASE(EpiResid, ws + WS_HID, ws + WS_DN1, D, FF, E); }
#endif
    GRID_SYNC();
    DBG_STOP(13);
#if !defined(PHMASK) || (PHMASK & (1 << 14))
    phase_final(F);
#endif
}

extern "C" void kernel_launch(void* const* d_in, const int* in_sizes, int n_in, void* d_out, int out_size, void* d_ws, size_t ws_size, hipStream_t stream) {
    static int grid = 0;
    if (grid == 0) {
        if (n_in != 19 || out_size != M * D || ws_size < WS_END) { fprintf(stderr, "kernel_launch: unexpected shapes (n_in %d out %d ws %zu)\n", n_in, out_size, ws_size); grid = -1; return; }
        int dev = 0, cus = 0, per_cu = 0;
        (void)hipGetDevice(&dev);
        (void)hipDeviceGetAttribute(&cus, hipDeviceAttributeMultiprocessorCount, dev);
        if (hipFuncSetAttribute((const void*)trunk_fwd, hipFuncAttributeMaxDynamicSharedMemorySize, LDS_BYTES) != hipSuccess) { fprintf(stderr, "kernel_launch: hipFuncSetAttribute failed\n"); grid = -1; return; }
        if (hipOccupancyMaxActiveBlocksPerMultiprocessor(&per_cu, (const void*)trunk_fwd, NTHR, LDS_BYTES) != hipSuccess || per_cu < 1) { fprintf(stderr, "kernel_launch: occupancy query says %d\n", per_cu); per_cu = 1; }
        (void)hipGetLastError();
        grid = cus * 1;
        if (grid > cus * per_cu) grid = cus * per_cu;
        fprintf(stderr, "kernel_launch: grid %d (cus %d, per_cu %d)\n", grid, cus, per_cu);
    }
    if (grid < 0) return;
    if (hipMemsetAsync((char*)d_ws + WS_CTL, 0, CTL_ZERO_BYTES, stream) != hipSuccess) { fprintf(stderr, "kernel_launch: memset failed\n"); return; }
    Args a{};
    for (int i = 0; i < 19; ++i) a.in[i] = (const float*)d_in[i];
    a.out = (float*)d_out; a.ws = (unsigned char*)d_ws;
    void* kargs[] = {&a};
    hipError_t e = hipLaunchCooperativeKernel((const void*)trunk_fwd, dim3(grid), dim3(NTHR), kargs, LDS_BYTES, stream);
    if (e != hipSuccess) fprintf(stderr, "kernel_launch: cooperative launch failed: %s (grid %d)\n", hipGetErrorString(e), grid);
}
```

```cpp
#include <hip/hip_runtime.h>
#include <hip/hip_cooperative_groups.h>
#include <cstdio>
#include <cstdint>
namespace cg = cooperative_groups;
namespace pg8 {
#define PG8_LAS __attribute__((address_space(3)))
typedef unsigned short bf16_t;
typedef short bf16x8 __attribute__((ext_vector_type(8)));
typedef float f32x4 __attribute__((ext_vector_type(4)));
typedef unsigned u32x4 __attribute__((ext_vector_type(4)));
constexpr int BM = 256, BK = 64, HALF = 128, HTB = HALF * BK * 2  , STAGE_BYTES = 8 * HTB, NXCD = 8, WGM = 8;

__host__ __device__ __forceinline__ int lds_byte(int r, int c) { const int st = (r >> 4) * 2 + (c >> 5), rr = r & 15, cc = c & 31, ob = rr * 64 + cc * 2; return st * 1024 + (ob ^ (((ob >> 9) & 1) << 5)); }
__host__ __device__ __forceinline__ void stage_rc(int b, int& R, int& C) { const int st = b / 1024, sb = b % 1024, swz = sb ^ (((sb >> 9) & 1) << 5); R = (st >> 1) * 16 + swz / 64; C = (st & 1) * 32 + (swz % 64) / 2; }
__host__ __device__ __forceinline__ int perm32(int rho) { const int n = rho >> 4, i = rho & 15; return 8 * (i >> 2) + 4 * n + (i & 3); }

struct Unit { int pm, pn; };
struct Gemm { const bf16_t* A; const bf16_t* Bt; int M, N, K; };

struct StaticOrder {
    int nM, nN, nwg, G, c;
    __host__ __device__ void init(int M, int N, int G_, int c_) { nM = M / BM; nN = N / BM; nwg = nM * nN; G = G_; c = c_; }
    __host__ __device__ bool next(int i, Unit& u) const {
        const long L = (long)i * G + c; if (L >= nwg) return false;
        int wgid = (int)L; { const int q = nwg / NXCD, r = nwg % NXCD, xcd = wgid % NXCD, off = wgid / NXCD; wgid = (xcd < r ? xcd * (q + 1) : r * (q + 1) + (xcd - r) * q) + off; }
        const int nig = WGM * nN, gid = wgid / nig, fm = gid * WGM, gsz = (nM - fm) < WGM ? (nM - fm) : WGM;
        u.pm = fm + ((wgid % nig) % gsz); u.pn = (wgid % nig) / gsz; return true;
    }
    __device__ __forceinline__ void a_ready(const Unit&) const {}
    __device__ __forceinline__ void done(const Unit&) const {}
};

__device__ __forceinline__ unsigned cvt_pk_bf16(float lo, float hi) { unsigned r; asm volatile("v_cvt_pk_bf16_f32 %0, %1, %2" : "=v"(r) : "v"(lo), "v"(hi)); return r; }
template <class Epi, class Sched, bool ALIGN_EPI = false, bool SP2 = false>
__device__ __forceinline__ void gemm_phase(PG8_LAS unsigned char* lds, const Gemm g, const Sched& S, const Epi& E) {
    const int tid = threadIdx.x, wid = __builtin_amdgcn_readfirstlane(tid >> 6), lane = tid & 63, wr = wid >> 2, wc = wid & 3, fr = lane & 15, fq = lane >> 4;
    const int K = g.K, nt = K / BK;
    unsigned voffA[2], voffB[2];
#pragma unroll
    for (int i = 0; i < 2; ++i) { int R, C; stage_rc(tid * 16 + i * 8192, R, C); const int Rb = Epi::PERM ? ((R & ~31) + perm32(R & 31)) : R;
        voffA[i] = (unsigned)(R * K + C) * 2u; voffB[i] = (unsigned)(Rb * K + C) * 2u; }
    const size_t kstep = (size_t)(BK * 2);
    const size_t hstep = (size_t)HALF * K * 2;
    const size_t tstep = 2 * hstep;
    const unsigned ldsw = (unsigned)wid * 1024u;
    const int aoff = lds_byte(wr * 64 + fr, fq * 8), boff = lds_byte(wc * 32 + fr, fq * 8);
#define PG8_SA(b, h) (((b) * 2 + (h)) * HTB)
#define PG8_SB(b, h) ((4 + (b) * 2 + (h)) * HTB)
#define PG8_STAGE(bufoff, gbase, voff) do { _Pragma("unroll") for (int _i = 0; _i < 2; ++_i) \
        __builtin_amdgcn_global_load_lds((const unsigned*)((const char*)(gbase) + (voff)[_i]), (PG8_LAS unsigned*)(lds + (bufoff) + ldsw + _i * 8192), 16, 0, 0); } while (0)
#define PG8_LDA(dst, b, h) do { _Pragma("unroll") for (int m = 0; m < 4; ++m) _Pragma("unroll") for (int k = 0; k < 2; ++k) dst[m][k] = *(const PG8_LAS bf16x8*)(lds + PG8_SA(b, h) + aoff + m * 2048 + k * 1024); } while (0)
#define PG8_LDB(dst, b, h) do { _Pragma("unroll") for (int n = 0; n < 2; ++n) _Pragma("unroll") for (int k = 0; k < 2; ++k) dst[n][k] = *(const PG8_LAS bf16x8*)(lds + PG8_SB(b, h) + boff + n * 2048 + k * 1024); } while (0)
#define PG8_MMA(ai, bj, At, Bt) do { __builtin_amdgcn_s_setprio(1); _Pragma("unroll") for (int m = 0; m < 4; ++m) _Pragma("unroll") for (int n = 0; n < 2; ++n) _Pragma("unroll") for (int k = 0; k < 2; ++k) \
        acc[ai][bj][m][n] = __builtin_amdgcn_mfma_f32_16x16x32_bf16(Bt[n][k], At[m][k], acc[ai][bj][m][n], 0, 0, 0); __builtin_amdgcn_s_setprio(0); } while (0)
#define PG8_WAIT_V(n) asm volatile("s_waitcnt vmcnt(" #n ")" ::: "memory")
#define PG8_WAIT_L(n) asm volatile("s_waitcnt lgkmcnt(" #n ")" ::: "memory")
#define PG8_BAR __builtin_amdgcn_s_barrier()
#define PG8_SCHED __builtin_amdgcn_sched_barrier(0)
    Unit cur, nxt; int ui = 0;
    if (!S.next(0, cur)) return;
    f32x4 acc[2][2][4][2];
#pragma unroll
    for (int a = 0; a < 2; ++a)
#pragma unroll
        for (int b = 0; b < 2; ++b)
#pragma unroll
            for (int m = 0; m < 4; ++m)
#pragma unroll
                for (int n = 0; n < 2; ++n) acc[a][b][m][n] = (f32x4){0.f, 0.f, 0.f, 0.f};
    bf16x8 At[4][2], B0[2][2], B1[2][2];
    const char* cA = (const char*)g.A + (size_t)cur.pm * tstep; const char* cB = (const char*)g.Bt + (size_t)cur.pn * tstep;
    S.a_ready(cur);
    if constexpr (SP2) {
        PG8_STAGE(PG8_SB(0, 0), cB, voffB); PG8_STAGE(PG8_SB(0, 1), cB + hstep, voffB); PG8_STAGE(PG8_SA(0, 0), cA, voffA); PG8_STAGE(PG8_SA(0, 1), cA + hstep, voffA);
        if (wr == 1) PG8_BAR;
        PG8_WAIT_V(2); PG8_BAR;
        PG8_STAGE(PG8_SB(1, 0), cB + kstep, voffB); PG8_STAGE(PG8_SA(1, 0), cA + kstep, voffA); PG8_STAGE(PG8_SB(1, 1), cB + hstep + kstep, voffB);
        PG8_WAIT_V(6); PG8_BAR;
    } else {
        PG8_STAGE(PG8_SB(0, 0), cB, voffB); PG8_STAGE(PG8_SA(0, 0), cA, voffA); PG8_STAGE(PG8_SB(0, 1), cB + hstep, voffB); PG8_STAGE(PG8_SA(0, 1), cA + hstep, voffA);
        if (wr == 1) PG8_BAR;
        PG8_WAIT_V(4); PG8_BAR;
        PG8_STAGE(PG8_SB(1, 0), cB + kstep, voffB); PG8_STAGE(PG8_SA(1, 0), cA + kstep, voffA); PG8_STAGE(PG8_SB(1, 1), cB + hstep + kstep, voffB);
        PG8_WAIT_V(6); PG8_BAR;
    }
    for (;;) {
        const bool has_next = S.next(ui + 1, nxt);
        const char* nA = has_next ? (const char*)g.A + (size_t)nxt.pm * tstep : cA; const char* nB = has_next ? (const char*)g.Bt + (size_t)nxt.pn * tstep : cB;
        for (int t = 0; t < nt; t += 2) {
            const bool last = (t == nt - 2);
            const char* a1 = cA + (size_t)(t + 1) * kstep;
            const char* a2 = last ? nA : cA + (size_t)(t + 2) * kstep; const char* b2 = last ? nB : cB + (size_t)(t + 2) * kstep;
            const char* a3 = a2 + kstep; const char* b3 = b2 + kstep;
            if (last && has_next) S.a_ready(nxt);
            if constexpr (SP2) {
            PG8_LDB(B0, 0, 0); PG8_LDB(B1, 0, 1); PG8_SCHED; PG8_LDA(At, 0, 0); PG8_STAGE(PG8_SA(1, 1), a1 + hstep, voffA);
            PG8_WAIT_V(8); PG8_WAIT_L(0); PG8_BAR; PG8_MMA(0, 0, At, B0); PG8_MMA(0, 1, At, B1); PG8_BAR; PG8_SCHED;
            PG8_LDA(At, 0, 1); PG8_STAGE(PG8_SB(0, 0), b2, voffB); PG8_STAGE(PG8_SB(0, 1), b2 + hstep, voffB); PG8_STAGE(PG8_SA(0, 0), a2, voffA);
            PG8_WAIT_V(8); PG8_WAIT_L(0); PG8_BAR; PG8_MMA(1, 0, At, B0); PG8_MMA(1, 1, At, B1); PG8_BAR; PG8_SCHED;
            PG8_LDB(B0, 1, 0); PG8_LDB(B1, 1, 1); PG8_SCHED; PG8_LDA(At, 1, 0); PG8_STAGE(PG8_SA(0, 1), a2 + hstep, voffA);
            PG8_WAIT_V(8); PG8_WAIT_L(0); PG8_BAR; PG8_MMA(0, 0, At, B0); PG8_MMA(0, 1, At, B1); PG8_BAR; PG8_SCHED;
            PG8_LDA(At, 1, 1); PG8_STAGE(PG8_SB(1, 0), b3, voffB); PG8_STAGE(PG8_SB(1, 1), b3 + hstep, voffB); PG8_STAGE(PG8_SA(1, 0), a3, voffA);
            PG8_WAIT_V(8); PG8_WAIT_L(0); PG8_BAR; PG8_MMA(1, 0, At, B0); PG8_MMA(1, 1, At, B1); PG8_BAR; PG8_SCHED;
            } else {
            PG8_LDB(B0, 0, 0); PG8_SCHED; PG8_LDA(At, 0, 0); PG8_STAGE(PG8_SA(1, 1), a1 + hstep, voffA);
            PG8_WAIT_L(8); PG8_BAR; PG8_WAIT_L(0); PG8_MMA(0, 0, At, B0); PG8_BAR; PG8_SCHED;
            PG8_LDB(B1, 0, 1); PG8_STAGE(PG8_SB(0, 0), b2, voffB);
            PG8_BAR; PG8_WAIT_L(0); PG8_MMA(0, 1, At, B1); PG8_BAR;
            PG8_LDA(At, 0, 1); PG8_STAGE(PG8_SA(0, 0), a2, voffA);
            PG8_BAR; PG8_WAIT_L(0); PG8_MMA(1, 0, At, B0); PG8_BAR; PG8_SCHED;
            PG8_STAGE(PG8_SB(0, 1), b2 + hstep, voffB);
            PG8_WAIT_V(6); PG8_BAR; PG8_MMA(1, 1, At, B1); PG8_BAR;
            PG8_LDB(B0, 1, 0); PG8_SCHED; PG8_LDA(At, 1, 0); PG8_STAGE(PG8_SA(0, 1), a2 + hstep, voffA);
            PG8_WAIT_L(8); PG8_BAR; PG8_WAIT_L(0); PG8_MMA(0, 0, At, B0); PG8_BAR; PG8_SCHED;
            PG8_LDB(B1, 1, 1); PG8_STAGE(PG8_SB(1, 0), b3, voffB);
            PG8_BAR; PG8_WAIT_L(0); PG8_MMA(0, 1, At, B1); PG8_BAR;
            PG8_LDA(At, 1, 1); PG8_STAGE(PG8_SA(1, 0), a3, voffA);
            PG8_BAR; PG8_WAIT_L(0); PG8_MMA(1, 0, At, B0); PG8_BAR; PG8_SCHED;
            PG8_STAGE(PG8_SB(1, 1), b3 + hstep, voffB);
            PG8_WAIT_V(6); PG8_BAR; PG8_MMA(1, 1, At, B1); PG8_BAR;
            }
        }
        if constexpr (ALIGN_EPI) { if (wr == 0) PG8_BAR; }
        if constexpr (!Epi::AFTER_DRAIN) { E(acc, cur, wr, wc, fr, fq); S.done(cur); }
        if (!has_next) break;
#pragma unroll
        for (int a = 0; a < 2; ++a)
#pragma unroll
            for (int b = 0; b < 2; ++b)
#pragma unroll
                for (int m = 0; m < 4; ++m)
#pragma unroll
                    for (int n = 0; n < 2; ++n) acc[a][b][m][n] = (f32x4){0.f, 0.f, 0.f, 0.f};
        cur = nxt; cA = nA; cB = nB; ++ui;
        if constexpr (ALIGN_EPI) { if (wr == 1) PG8_BAR; }
    }
    PG8_WAIT_V(0);
    if constexpr (!ALIGN_EPI) { if (wr == 0) PG8_BAR; }
    PG8_BAR;
    if constexpr (Epi::AFTER_DRAIN) { E.fused(acc, cur, wr, wc, fr, fq, lds, wid, lane); S.done(cur); }
#undef PG8_SA
#undef PG8_SB
#undef PG8_STAGE
#undef PG8_LDA
#undef PG8_LDB
#undef PG8_MMA
#undef PG8_WAIT_V
#undef PG8_WAIT_L
#undef PG8_BAR
#undef PG8_SCHED
}
}

#define LAS __attribute__((address_space(3)))
typedef unsigned short bf16;
typedef unsigned v4u __attribute__((ext_vector_type(4)));
typedef unsigned v2u __attribute__((ext_vector_type(2)));
typedef float f32x4 __attribute__((ext_vector_type(4)));
typedef short bf16x8 __attribute__((ext_vector_type(8)));
constexpr int M = 16384, D = 1024, T = 4096, FF = 2816, NUP = 2 * FF, NIN0 = 1536, NHG = 4096;
constexpr float EPS = 1e-6f;
constexpr int NWAVES = 8, NTHR = 512;
constexpr int LDS_BYTES = 147456;
constexpr size_t MiB = 1u << 20;
constexpr size_t WS_WIN0 = 0, WS_WOUT0 = 3 * MiB, WS_PW = 5 * MiB, WS_UP0 = 5 * MiB + 512 * 1024, WS_DN0 = 16 * MiB + 512 * 1024, WS_HGIN = 22 * MiB;
constexpr size_t WS_HB = 30 * MiB;
constexpr size_t WS_Z = 64 * MiB;
constexpr size_t WS_AG = WS_Z, WS_UU = WS_Z + 16 * MiB, WS_CAT = WS_Z + 32 * MiB, WS_DD = WS_Z + 64 * MiB;
constexpr size_t WS_HID = WS_Z;
constexpr size_t WS_Q = WS_Z, WS_F = WS_Z + 32 * MiB, WS_V = WS_Z + 96 * MiB, WS_G = WS_Z + 128 * MiB;
constexpr size_t WS_U = 0;
constexpr size_t WS_HGOUT = 224 * MiB, WS_UP1 = 226 * MiB, WS_DN1 = 237 * MiB;
constexpr size_t WS_SS = 246 * MiB;
constexpr size_t WS_DEC = 244 * MiB;
constexpr size_t WS_CTL = 245 * MiB, CTL_ZERO_BYTES = 64 * 1024;
constexpr size_t WS_END = 251 * MiB;
constexpr int SSN = M * 16;
constexpr int LDSCTL_OFF = 131072, MISC_OFF = LDSCTL_OFF + 320;

__device__ __forceinline__ float wave_sum(float v) {
#pragma unroll
    for (int o = 1; o < 64; o <<= 1) v += __shfl_xor(v, o);
    return v;
}
typedef float f32x2_t __attribute__((ext_vector_type(2)));
typedef __bf16 bf16x2_t __attribute__((ext_vector_type(2)));
__device__ __forceinline__ unsigned pk2(float lo, float hi) { f32x2_t v = {lo, hi}; bf16x2_t b = __builtin_convertvector(v, bf16x2_t); return __builtin_bit_cast(unsigned, b); }
__device__ __forceinline__ float bflo(unsigned w) { return __uint_as_float(w << 16); }
__device__ __forceinline__ float bfhi(unsigned w) { return __uint_as_float(w & 0xffff0000u); }
__device__ __forceinline__ float sigmoidf_(float x) { return __builtin_amdgcn_rcpf(1.0f + __expf(-x)); }
#define LDS_WAIT() asm volatile("s_waitcnt lgkmcnt(0)" ::: "memory")
__device__ __forceinline__ float row_rstd(const float* ss, int row) {
    const f32x4* p = (const f32x4*)(ss + (size_t)row * 16);
    const f32x4 a = p[0], b = p[1], c = p[2], d = p[3];
    const float s = ((a[0] + a[1]) + (a[2] + a[3])) + ((b[0] + b[1]) + (b[2] + b[3])) + (((c[0] + c[1]) + (c[2] + c[3])) + ((d[0] + d[1]) + (d[2] + d[3])));
    return rsqrtf(s * (1.0f / D) + EPS);
}

using pg8::Unit;
typedef float accf4 __attribute__((ext_vector_type(4)));

struct EpiInCP {
    static constexpr bool PERM = true, AFTER_DRAIN = false;
    bf16* AG; bf16* UU; const float* ss;
    __device__ __forceinline__ void operator()(const accf4 (&acc)[2][2][4][2], const Unit& u, int wr, int wc, int fr, int fq) const {
        const int row0 = u.pm * 256 + wr * 64 + fr;
#pragma unroll
        for (int ai = 0; ai < 2; ++ai)
#pragma unroll
            for (int m = 0; m < 4; ++m) {
                const int row = row0 + ai * 128 + m * 16;
                const float rs = row_rstd(ss, row);
                if (u.pn < 4) {
                    float o[8];
#pragma unroll
                    for (int n = 0; n < 2; ++n)
#pragma unroll
                        for (int i = 0; i < 4; ++i) { const float v = acc[ai][0][m][n][i] * rs, g = acc[ai][1][m][n][i] * rs; o[4 * n + i] = v * sigmoidf_(g); }
                    v4u w; w.x = pk2(o[0], o[1]); w.y = pk2(o[2], o[3]); w.z = pk2(o[4], o[5]); w.w = pk2(o[6], o[7]);
                    *(v4u*)(AG + (size_t)row * 512 + 128 * u.pn + 32 * wc + 8 * fq) = w;
                } else {
#pragma unroll
                    for (int bj = 0; bj < 2; ++bj) {
                        const accf4 a0 = acc[ai][bj][m][0] * rs, a1 = acc[ai][bj][m][1] * rs;
                        v4u w; w.x = pk2(a0[0], a0[1]); w.y = pk2(a0[2], a0[3]); w.z = pk2(a1[0], a1[1]); w.w = pk2(a1[2], a1[3]);
                        *(v4u*)(UU + (size_t)row * 512 + 256 * (u.pn - 4) + 128 * bj + 32 * wc + 8 * fq) = w;
                    }
                }
            }
    }
};
struct EpiPool {
    static constexpr bool PERM = true, AFTER_DRAIN = false;
    bf16* CAT; const float* scale;
    __device__ __forceinline__ void operator()(const accf4 (&acc)[2][2][4][2], const Unit& u, int wr, int wc, int fr, int fq) const {
        const int row0 = u.pm * 256 + wr * 64 + fr;
#pragma unroll
        for (int bj = 0; bj < 2; ++bj) {
            const int col = 256 * u.pn + 128 * bj + 32 * wc + 8 * fq;
            const accf4 s0 = *(const accf4*)(scale + col), s1 = *(const accf4*)(scale + col + 4);
#pragma unroll
            for (int ai = 0; ai < 2; ++ai)
#pragma unroll
                for (int m = 0; m < 4; ++m) {
                    const int row = row0 + ai * 128 + m * 16;
                    const accf4 a0 = acc[ai][bj][m][0] * s0, a1 = acc[ai][bj][m][1] * s1;
                    v4u w; w.x = pk2(a0[0], a0[1]); w.y = pk2(a0[2], a0[3]); w.z = pk2(a1[0], a1[1]); w.w = pk2(a1[2], a1[3]);
                    *(v4u*)(CAT + (size_t)row * 1024 + 512 + col) = w;
                }
        }
    }
};
struct EpiResid {
    static constexpr bool PERM = true, AFTER_DRAIN = false;
    const bf16* hbi; bf16* hbo; float* outf; float* ssn;
    __device__ __forceinline__ void operator()(const accf4 (&acc)[2][2][4][2], const Unit& u, int wr, int wc, int fr, int fq) const {
        const int row0 = u.pm * 256 + wr * 64 + fr, colb = 256 * u.pn + 32 * wc + 8 * fq;
#pragma unroll
        for (int ai = 0; ai < 2; ++ai) {
            v4u rv[4][2];
#pragma unroll
            for (int m = 0; m < 4; ++m)
#pragma unroll
                for (int bj = 0; bj < 2; ++bj) rv[m][bj] = *(const v4u*)(hbi + (size_t)(row0 + ai * 128 + m * 16) * D + colb + 128 * bj);
#pragma unroll
            for (int m = 0; m < 4; ++m) {
                const int row = row0 + ai * 128 + m * 16;
                float p = 0.f;
#pragma unroll
                for (int bj = 0; bj < 2; ++bj) {
                    const size_t off = (size_t)row * D + colb + 128 * bj;
                    const v4u r = rv[m][bj];
                    accf4 o0, o1;
                    o0[0] = bflo(r.x) + acc[ai][bj][m][0][0]; o0[1] = bfhi(r.x) + acc[ai][bj][m][0][1]; o0[2] = bflo(r.y) + acc[ai][bj][m][0][2]; o0[3] = bfhi(r.y) + acc[ai][bj][m][0][3];
                    o1[0] = bflo(r.z) + acc[ai][bj][m][1][0]; o1[1] = bfhi(r.z) + acc[ai][bj][m][1][1]; o1[2] = bflo(r.w) + acc[ai][bj][m][1][2]; o1[3] = bfhi(r.w) + acc[ai][bj][m][1][3];
                    p += (o0[0] * o0[0] + o0[1] * o0[1]) + (o0[2] * o0[2] + o0[3] * o0[3]) + (o1[0] * o1[0] + o1[1] * o1[1]) + (o1[2] * o1[2] + o1[3] * o1[3]);
                    if (outf) { *(accf4*)(outf + off) = o0; *(accf4*)(outf + off + 4) = o1; }
                    else { v4u w; w.x = pk2(o0[0], o0[1]); w.y = pk2(o0[2], o0[3]); w.z = pk2(o1[0], o1[1]); w.w = pk2(o1[2], o1[3]); *(v4u*)(hbo + off) = w; }
                }
                p += __shfl_xor(p, 16); p += __shfl_xor(p, 32);
                if (fq == 0) ssn[(size_t)row * 16 + u.pn * 4 + wc] = p;
            }
        }
    }
};
struct EpiSwiGLU {
    static constexpr bool PERM = true, AFTER_DRAIN = false;
    bf16* HID; const float* ss;
    __device__ __forceinline__ void operator()(const accf4 (&acc)[2][2][4][2], const Unit& u, int wr, int wc, int fr, int fq) const {
        const int row0 = u.pm * 256 + wr * 64 + fr;
#pragma unroll
        for (int ai = 0; ai < 2; ++ai)
#pragma unroll
            for (int m = 0; m < 4; ++m) {
                const int row = row0 + ai * 128 + m * 16;
                const float rs = row_rstd(ss, row);
                float o[8];
#pragma unroll
                for (int n = 0; n < 2; ++n)
#pragma unroll
                    for (int i = 0; i < 4; ++i) { const float a = acc[ai][0][m][n][i] * rs, b = acc[ai][1][m][n][i] * rs; o[4 * n + i] = a * sigmoidf_(a) * b; }
                v4u w; w.x = pk2(o[0], o[1]); w.y = pk2(o[2], o[3]); w.z = pk2(o[4], o[5]); w.w = pk2(o[6], o[7]);
                *(v4u*)(HID + (size_t)row * FF + 128 * u.pn + 32 * wc + 8 * fq) = w;
            }
    }
};
struct EpiHgIn {
    static constexpr bool PERM = true, AFTER_DRAIN = false;
    bf16* Q; float* Fl; bf16* V; bf16* G; const float* ss; const float* lbl;
    __device__ __forceinline__ void operator()(const accf4 (&acc)[2][2][4][2], const Unit& u, int wr, int wc, int fr, int fq) const {
        const int row0 = u.pm * 256 + wr * 64 + fr, sec = u.pn >> 2, cb = 256 * (u.pn & 3) + 32 * wc + 8 * fq;
        if (sec == 1) {
#pragma unroll
            for (int bj = 0; bj < 2; ++bj) {
                const int col = cb + 128 * bj;
                float lb[8];
#pragma unroll
                for (int j = 0; j < 8; ++j) lb[j] = 1.0f / (1.0f + expf(lbl[col + j] - lbl[D + col + j]));
#pragma unroll
                for (int ai = 0; ai < 2; ++ai)
#pragma unroll
                    for (int m = 0; m < 4; ++m) {
                        const int row = row0 + ai * 128 + m * 16;
                        const float rs = row_rstd(ss, row);
                        accf4 o0, o1;
#pragma unroll
                        for (int i = 0; i < 4; ++i) {
                            const float z0 = acc[ai][bj][m][0][i] * rs, z1 = acc[ai][bj][m][1][i] * rs;
                            o0[i] = logf(lb[i] + (1.0f - lb[i]) * sigmoidf_(z0));
                            o1[i] = logf(lb[4 + i] + (1.0f - lb[4 + i]) * sigmoidf_(z1));
                        }
                        float* p = Fl + (size_t)row * D + col;
                        *(accf4*)p = o0; *(accf4*)(p + 4) = o1;
                    }
            }
        } else {
            bf16* O = Q + (sec ? (size_t)(sec + 1) * (16u << 20) : (size_t)0);
#pragma unroll
            for (int ai = 0; ai < 2; ++ai)
#pragma unroll
                for (int m = 0; m < 4; ++m) {
                    const int row = row0 + ai * 128 + m * 16;
                    const float rs = row_rstd(ss, row);
#pragma unroll
                    for (int bj = 0; bj < 2; ++bj) {
                        accf4 a0 = acc[ai][bj][m][0] * rs, a1 = acc[ai][bj][m][1] * rs;
                        if (sec == 3) {
#pragma unroll
                            for (int i = 0; i < 4; ++i) { a0[i] = a0[i] * sigmoidf_(a0[i]); a1[i] = a1[i] * sigmoidf_(a1[i]); }
                        }
                        v4u w; w.x = pk2(a0[0], a0[1]); w.y = pk2(a0[2], a0[3]); w.z = pk2(a1[0], a1[1]); w.w = pk2(a1[2], a1[3]);
                        *(v4u*)(O + (size_t)row * D + cb + 128 * bj) = w;
                    }
                }
        }
    }
};

#define XB_TMO      128
#define XB_XCNT(j)  (256  + 64 * (j))
#define XB_XSUB(j)  (1280 + 64 * (j))
#define XB_XGEN(j)  (2304 + 64 * (j))
#define XB_TOP      3328
#define XB_TOPGEN   3392
#define XCD_BAR_WORDS 3456
#define XB_SPIN_CAP (1u << 18)

__device__ __forceinline__ unsigned xb_ld(unsigned* p)              { return __hip_atomic_load(p, __ATOMIC_RELAXED, __HIP_MEMORY_SCOPE_AGENT); }
__device__ __forceinline__ unsigned xb_add(unsigned* p, unsigned v) { return __hip_atomic_fetch_add(p, v, __ATOMIC_RELAXED, __HIP_MEMORY_SCOPE_AGENT); }
__device__ __forceinline__ unsigned xb_xcc_id() { return (unsigned)__builtin_amdgcn_s_getreg((3 << 11) | 20) & 0xFu; }
#define XB_SPIN(cond, bar) do { unsigned _sp = 0; while (cond) { __builtin_amdgcn_s_sleep(1); \
    if ((++_sp & 255u) == 0u) { if (xb_ld(&(bar)[XB_TMO])) break; if (_sp > XB_SPIN_CAP) { atomicAdd(&(bar)[XB_TMO], 1u); break; } } } } while (0)

struct XcdBarrier {
    unsigned* bar; unsigned x;
    volatile LAS unsigned* st;
};

__device__ __forceinline__ XcdBarrier xcd_barrier_post(unsigned* bar, volatile LAS unsigned* st) {
    XcdBarrier b; b.bar = bar; b.x = xb_xcc_id(); b.st = st;
    if (threadIdx.x == 0) (void)xb_add(&bar[XB_XCNT(b.x)], 1u);
    return b;
}
__device__ __forceinline__ void xcd_barrier_complete(unsigned* bar, unsigned x, unsigned& nloc, unsigned& nx) {
    const unsigned G = gridDim.x * gridDim.y * gridDim.z;
    unsigned sum, cnt, mine, sp = 0u;
    for (;;) {
        sum = 0u; cnt = 0u; mine = 0u;
#pragma unroll
        for (unsigned j = 0; j < 16; ++j) { const unsigned c = xb_ld(&bar[XB_XCNT(j)]); sum += c; cnt += (c > 0u) ? 1u : 0u; mine = (j == x) ? c : mine; }
        if (sum == G) break;
        __builtin_amdgcn_s_sleep(1);
        if ((++sp & 255u) == 0u) { if (xb_ld(&bar[XB_TMO])) break; if (sp > XB_SPIN_CAP) { atomicAdd(&bar[XB_TMO], 1u); break; } }
    }
    nloc = mine > 0u ? mine : 1u; nx = cnt > 0u ? cnt : 1u;
}

__device__ __forceinline__ void xcd_barrier(const XcdBarrier& b) {
    asm volatile("s_waitcnt vmcnt(0)" ::: "memory");
    __syncthreads();
    if (threadIdx.x == 0) {
        unsigned* bar = b.bar;
        __builtin_amdgcn_s_waitcnt(0);
        unsigned nloc = b.st[0], nx = b.st[1];
        if (nloc == 0u) { xcd_barrier_complete(bar, b.x, nloc, nx); b.st[0] = nloc; b.st[1] = nx; }
        const unsigned old = xb_add(&bar[XB_XSUB(b.x)], 1u);
        const unsigned gen = old / nloc;
        if (old + 1u == (gen + 1u) * nloc) {
            __builtin_amdgcn_fence(__ATOMIC_RELEASE, "agent");
            asm volatile("s_waitcnt vmcnt(0)" ::: "memory");
            const unsigned og = xb_add(&bar[XB_TOP], 1u);
            const unsigned tg = og / nx;
            if (og + 1u == (tg + 1u) * nx) xb_add(&bar[XB_TOPGEN], 1u);
            else XB_SPIN(xb_ld(&bar[XB_TOPGEN]) == tg, bar);
            __builtin_amdgcn_fence(__ATOMIC_ACQUIRE, "agent");
            xb_add(&bar[XB_XGEN(b.x)], 1u);
            asm volatile("s_waitcnt vmcnt(0)" ::: "memory");
        } else {
            XB_SPIN(xb_ld(&bar[XB_XGEN(b.x)]) == gen, bar);
            __builtin_amdgcn_fence(__ATOMIC_ACQUIRE, "agent");
            asm volatile("s_waitcnt vmcnt(0)" ::: "memory");
        }
    }
    __syncthreads();
}
struct Args { const float* in[19]; float* out; unsigned char* ws; };
struct Frame {
    LAS unsigned char* lds;
    int tid, lane, wave, G, bid;
    const float* const* in; float* out; unsigned char* ws;
};

__device__ __forceinline__ void tr_item(const float* W, int N, int k0, int n0, bf16* dst, int ldk, const float* g, LAS float* scr, int lane) {
    float wv[32];
#pragma unroll
    for (int i = 0; i < 32; ++i) { const int kk = 2 * i + (lane >> 5); wv[i] = W[(size_t)(k0 + kk) * N + n0 + (lane & 31)]; }
    if (g) {
#pragma unroll
        for (int i = 0; i < 32; ++i) wv[i] *= g[k0 + 2 * i + (lane >> 5)];
    }
#pragma unroll
    for (int i = 0; i < 32; ++i) scr[(2 * i + (lane >> 5)) * 33 + (lane & 31)] = wv[i];
    LDS_WAIT(); asm volatile("" ::: "memory");
    const int c = lane & 7;
#pragma unroll
    for (int j = 0; j < 4; ++j) { const int n = (lane >> 3) + 8 * j; const LAS float* s = scr + (8 * c) * 33 + n;
        v4u o; o.x = pk2(s[0 * 33], s[1 * 33]); o.y = pk2(s[2 * 33], s[3 * 33]); o.z = pk2(s[4 * 33], s[5 * 33]); o.w = pk2(s[6 * 33], s[7 * 33]);
        *(v4u*)(dst + (size_t)n * ldk + 8 * c) = o; }
    LDS_WAIT(); asm volatile("" ::: "memory");
}
__device__ __forceinline__ int map_row(int type, int n0) {
    if (type == 0) return n0;
    if (type == 1) return 256 * (n0 >> 7) + (n0 & 127);
    if (type == 2) return 256 * (n0 >> 7) + 128 + (n0 & 127);
    if (n0 < 512) return 256 * (n0 >> 7) + (n0 & 127);
    if (n0 < 1024) return 256 * ((n0 - 512) >> 7) + 128 + (n0 & 127);
    return n0;
}
__device__ __forceinline__ void tr_job(const float* W, int K, int N, bf16* WT, const float* g, int type, int item, LAS float* scr, int lane) {
    const int nblk = N / 32, kb = item / nblk, nb = item % nblk, k0 = 64 * kb, n0 = 32 * nb;
    tr_item(W, N, k0, n0, WT + (size_t)map_row(type, n0) * K + k0, K, g, scr, lane);
}

__device__ __forceinline__ void p0_prologue(Frame& F) {
    LAS float* scr = (LAS float*)(F.lds + F.wave * 16384);
    const int gw = F.bid * NWAVES + F.wave, NGW = F.G * NWAVES;
    unsigned char* ws = F.ws;
    constexpr int I_IN0 = 16 * 48, I_SQ = 16 * 32, I_UP = 16 * 88, I_DN = 44 * 32, I_HG = 16 * 128;
    constexpr int I_SQH = 8 * 32;
    constexpr int NITEMS = I_IN0 + I_SQH + 2 * (2 * I_UP + I_DN) + I_HG + I_SQ;
    for (int it = gw; it < NITEMS; it += NGW) {
        int r = it;
        if (r < I_IN0) { tr_job(F.in[4], D, NIN0, (bf16*)(ws + WS_WIN0), F.in[1], 3, r, scr, F.lane); continue; } r -= I_IN0;
        if (r < I_SQH) { tr_job(F.in[11], D, D, (bf16*)(ws + WS_WOUT0), nullptr, 0, r, scr, F.lane); continue; } r -= I_SQH;
        if (r < I_UP) { tr_job(F.in[16], D, FF, (bf16*)(ws + WS_UP0), F.in[2], 1, r, scr, F.lane); continue; } r -= I_UP;
        if (r < I_UP) { tr_job(F.in[17], D, FF, (bf16*)(ws + WS_UP0), F.in[2], 2, r, scr, F.lane); continue; } r -= I_UP;
        if (r < I_DN) { tr_job(F.in[18], FF, D, (bf16*)(ws + WS_DN0), nullptr, 0, r, scr, F.lane); continue; } r -= I_DN;
        if (r < I_HG) { tr_job(F.in[12], D, NHG, (bf16*)(ws + WS_HGIN), F.in[1] + D, 0, r, scr, F.lane); continue; } r -= I_HG;
        if (r < I_SQ) { tr_job(F.in[15], D, D, (bf16*)(ws + WS_HGOUT), nullptr, 0, r, scr, F.lane); continue; } r -= I_SQ;
        if (r < I_UP) { tr_job(F.in[16] + (size_t)D * FF, D, FF, (bf16*)(ws + WS_UP1), F.in[2] + D, 1, r, scr, F.lane); continue; } r -= I_UP;
        if (r < I_UP) { tr_job(F.in[17] + (size_t)D * FF, D, FF, (bf16*)(ws + WS_UP1), F.in[2] + D, 2, r, scr, F.lane); continue; } r -= I_UP;
        tr_job(F.in[18] + (size_t)D * FF, FF, D, (bf16*)(ws + WS_DN1), nullptr, 0, r, scr, F.lane);
    }
    {
        const float* pw = F.in[9]; const float* psc = F.in[10]; const float* wo = F.in[11]; bf16* WT = (bf16*)(ws + WS_WOUT0);
        for (int it = gw; it < 4 * 32 * 4; it += NGW) {
            const int g = it >> 7, cq = (it >> 2) & 31, nb = it & 3, n0 = nb * 256 + 4 * F.lane;
            f32x4 acc[4];
#pragma unroll
            for (int j = 0; j < 4; ++j) acc[j] = (f32x4){0.f, 0.f, 0.f, 0.f};
            const float* pwr = pw + (size_t)g * 16384 + (size_t)(4 * cq) * 128;
            const float* wor = wo + (size_t)(512 + 128 * g) * D + n0;
#pragma unroll 4
            for (int d = 0; d < 128; ++d) {
                const f32x4 wv = *(const f32x4*)(wor + (size_t)d * D);
                const float sc = psc[128 * g + d];
#pragma unroll
                for (int j = 0; j < 4; ++j) acc[j] += wv * (pwr[j * 128 + d] * sc);
            }
#pragma unroll
            for (int j = 0; j < 4; ++j)
#pragma unroll
                for (int i = 0; i < 4; ++i) WT[(size_t)(n0 + i) * D + 512 + 128 * g + 4 * cq + j] = (bf16)(pk2(acc[j][i], 0.f) & 0xffffu);
        }
    }
    float* ss = (float*)(ws + WS_SS);
    const float* x = F.in[0]; bf16* HB = (bf16*)F.out;
    for (int m4 = gw * 4; m4 < M; m4 += NGW * 4) {
        f32x4 v[4][4];
#pragma unroll
        for (int r = 0; r < 4; ++r) { const f32x4* xr = (const f32x4*)(x + (size_t)(m4 + r) * D) + F.lane;
#pragma unroll
            for (int j = 0; j < 4; ++j) v[r][j] = xr[64 * j]; }
#pragma unroll
        for (int r = 0; r < 4; ++r) {
            float s = 0.f;
#pragma unroll
            for (int j = 0; j < 4; ++j) s += (v[r][j][0] * v[r][j][0] + v[r][j][1] * v[r][j][1]) + (v[r][j][2] * v[r][j][2] + v[r][j][3] * v[r][j][3]);
            s = wave_sum(s);
            if (F.lane < 16) ss[(size_t)(m4 + r) * 16 + F.lane] = F.lane == 0 ? s : 0.f;
            v2u* o8 = (v2u*)(HB + (size_t)(m4 + r) * D) + F.lane;
#pragma unroll
            for (int j = 0; j < 4; ++j) { v2u w; w.x = pk2(v[r][j][0], v[r][j][1]); w.y = pk2(v[r][j][2], v[r][j][3]); o8[64 * j] = w; }
        }
    }
}

__device__ __forceinline__ void phase_convpool(Frame& F) {
    LAS float* wl = (LAS float*)F.lds;
    LAS unsigned char* at = F.lds + 63488;
    const float* dw_w = F.in[5]; const float* dw_b = F.in[6]; const float* ln_g = F.in[7]; const float* ln_b = F.in[8];
    const bf16* AG = (const bf16*)(F.ws + WS_AG); const bf16* UU = (const bf16*)(F.ws + WS_UU);
    bf16* CAT = (bf16*)(F.ws + WS_CAT);
    const int tid = F.tid, lane = F.lane, w = F.wave;
    for (int e = tid; e < 31 * 128; e += NTHR) { const int j = e >> 7, q4 = e & 127;
        const f32x4 v = *(const f32x4*)(dw_w + j * 512 + 4 * q4);
        *(LAS f32x4*)(wl + ((j * 2 + (q4 & 1)) * 64 + (q4 >> 1)) * 4) = v; }
    const int PW_ = 2 << (lane >> 4);
    for (int tile = F.bid; tile < M / 32; tile += F.G) {
        const int m0 = tile * 32, tpos0 = m0 & (T - 1);
        __syncthreads();
        for (int e = tid; e < 64 * 64; e += NTHR) { const int rr = e >> 6, ch = e & 63; v4u v = (v4u){0u, 0u, 0u, 0u};
            if (tpos0 - 30 + rr >= 0 && rr < 62) v = *(const v4u*)(AG + (size_t)(m0 - 30 + rr) * 512 + ch * 8);
            *(LAS v4u*)(at + rr * 1024 + ch * 16) = v; }
        __syncthreads();
        float acc[4][8];
        {
            const f32x4 b0 = *(const f32x4*)(dw_b + lane * 8), b1 = *(const f32x4*)(dw_b + lane * 8 + 4);
#pragma unroll
            for (int tt = 0; tt < 4; ++tt)
#pragma unroll
                for (int i = 0; i < 4; ++i) { acc[tt][i] = b0[i]; acc[tt][4 + i] = b1[i]; }
        }
        float wreg[4][8];
#pragma unroll
        for (int rr = 0; rr < 4; ++rr)
#pragma unroll
            for (int i = 0; i < 8; ++i) wreg[rr][i] = 0.f;
#pragma unroll 1
        for (int rb = 0; rb < 9; ++rb) {
#pragma unroll
            for (int rr = 0; rr < 4; ++rr) {
                const int r = 4 * rb + rr;
                const v4u av = *(const LAS v4u*)(at + (4 * w + r) * 1024 + lane * 16);
                float a[8]; a[0] = bflo(av.x); a[1] = bfhi(av.x); a[2] = bflo(av.y); a[3] = bfhi(av.y); a[4] = bflo(av.z); a[5] = bfhi(av.z); a[6] = bflo(av.w); a[7] = bfhi(av.w);
                f32x4 w0 = (f32x4){0.f, 0.f, 0.f, 0.f}, w1 = w0;
                if (r <= 30) { w0 = *(const LAS f32x4*)(wl + ((r * 2 + 0) * 64 + lane) * 4); w1 = *(const LAS f32x4*)(wl + ((r * 2 + 1) * 64 + lane) * 4); }
#pragma unroll
                for (int i = 0; i < 4; ++i) { wreg[rr][i] = w0[i]; wreg[rr][4 + i] = w1[i]; }
#pragma unroll
                for (int tt = 0; tt < 4; ++tt) {
#pragma unroll
                    for (int i = 0; i < 8; ++i) acc[tt][i] += wreg[(rr - tt) & 3][i] * a[i]; }
            }
        }
        float lg[8], lb[8];
        {
            const f32x4 g0 = *(const f32x4*)(ln_g + lane * 8), g1 = *(const f32x4*)(ln_g + lane * 8 + 4), c0 = *(const f32x4*)(ln_b + lane * 8), c1 = *(const f32x4*)(ln_b + lane * 8 + 4);
#pragma unroll
            for (int i = 0; i < 4; ++i) { lg[i] = g0[i]; lg[4 + i] = g1[i]; lb[i] = c0[i]; lb[4 + i] = c1[i]; }
        }
#pragma unroll
        for (int tt = 0; tt < 4; ++tt) {
            float s = 0.f;
#pragma unroll
            for (int i = 0; i < 8; ++i) s += acc[tt][i];
            const float mean = wave_sum(s) * (1.0f / 512.0f);
            float q = 0.f;
#pragma unroll
            for (int i = 0; i < 8; ++i) { acc[tt][i] -= mean; q += acc[tt][i] * acc[tt][i]; }
            const float rstd = rsqrtf(wave_sum(q) * (1.0f / 512.0f) + EPS);
            float o[8];
#pragma unroll
            for (int i = 0; i < 8; ++i) { const float y = acc[tt][i] * rstd * lg[i] + lb[i]; o[i] = y * sigmoidf_(y); }
            v4u wv; wv.x = pk2(o[0], o[1]); wv.y = pk2(o[2], o[3]); wv.z = pk2(o[4], o[5]); wv.w = pk2(o[6], o[7]);
            *(v4u*)(CAT + (size_t)(m0 + 4 * w + tt) * 1024 + lane * 8) = wv;
        }
        {
            const int mb = m0 + 4 * w, tb = tpos0 + 4 * w;
            float sum[4][8], self[4][8];
#pragma unroll
            for (int tt = 0; tt < 4; ++tt)
#pragma unroll
                for (int i = 0; i < 8; ++i) { sum[tt][i] = 0.f; self[tt][i] = 0.f; }
#pragma unroll
            for (int r = 0; r < 19; ++r) {
                if (tb - 15 + r < 0) continue;
                const v4u uv = *(const v4u*)(UU + (size_t)(mb - 15 + r) * 512 + lane * 8);
                float a[8]; a[0] = bflo(uv.x); a[1] = bfhi(uv.x); a[2] = bflo(uv.y); a[3] = bfhi(uv.y); a[4] = bflo(uv.z); a[5] = bfhi(uv.z); a[6] = bflo(uv.w); a[7] = bfhi(uv.w);
#pragma unroll
                for (int tt = 0; tt < 4; ++tt) { const int i_ = 15 + tt - r; if (i_ >= 0 && i_ < 16) {
                    const bool in = i_ < PW_;
#pragma unroll
                    for (int i = 0; i < 8; ++i) { sum[tt][i] += in ? a[i] : 0.f; if (i_ == 0) self[tt][i] = a[i]; } } }
            }
#pragma unroll
            for (int tt = 0; tt < 4; ++tt) {
                const int tp = tb + tt; const int cnt = (tp + 1) < PW_ ? (tp + 1) : PW_;
                const float inv = 1.0f / (float)cnt;
                float o[8];
#pragma unroll
                for (int i = 0; i < 8; ++i) o[i] = sum[tt][i] * inv - self[tt][i];
                v4u wv; wv.x = pk2(o[0], o[1]); wv.y = pk2(o[2], o[3]); wv.z = pk2(o[4], o[5]); wv.w = pk2(o[6], o[7]);
                *(v4u*)(CAT + (size_t)(mb + tt) * 1024 + 512 + lane * 8) = wv;
            }
        }
    }
    __syncthreads();
}

constexpr int KT_P = 72;
constexpr int QS_P = 136;
__device__ __forceinline__ void phase_hg_state(Frame& F) {
    LAS float* Bf = (LAS float*)F.lds;
    LAS float* tot = (LAS float*)(F.lds + 32768);
    LAS bf16* KT = (LAS bf16*)(F.lds + 34816);
    LAS bf16* VT = (LAS bf16*)(F.lds + 34816 + 128 * KT_P * 2);
    const float* Fl = (const float*)(F.ws + WS_F); const bf16* V = (const bf16*)(F.ws + WS_V);
    bf16* U = (bf16*)(F.ws + WS_U); float* DEC = (float*)(F.ws + WS_DEC);
    const int tid = F.tid, lane = F.lane, w = F.wave, c = tid & 127, qd = tid >> 7, l16 = lane & 15, lq = lane >> 4;
    for (int unit = F.bid; unit < 2048; unit += F.G) {
        const int bh = unit >> 6, chunk = unit & 63, b = bh >> 3, h = bh & 7;
        const size_t m0 = (size_t)b * T + chunk * 64; const int c0 = h * 128;
        __syncthreads();
        for (int e = tid; e < 2048; e += NTHR) { const int s = e >> 5, c4 = e & 31;
            *(LAS f32x4*)(Bf + s * 128 + c4 * 4) = *(const f32x4*)(Fl + (m0 + s) * D + c0 + c4 * 4); }
        unsigned vv[8];
#pragma unroll
        for (int i = 0; i < 8; ++i) { const unsigned lo = V[(m0 + 16 * qd + 2 * i) * D + c0 + c], hi = V[(m0 + 16 * qd + 2 * i + 1) * D + c0 + c]; vv[i] = lo | (hi << 16); }
        __syncthreads();
        float lf[16], bs[16]; float run = 0.f;
#pragma unroll
        for (int i = 0; i < 16; ++i) { lf[i] = Bf[(16 * qd + i) * 128 + c]; run += lf[i]; bs[i] = run; }
        tot[qd * 128 + c] = run;
        __syncthreads();
        float pre = 0.f, total = 0.f;
#pragma unroll
        for (int q = 0; q < 4; ++q) { const float t = tot[q * 128 + c]; total += t; if (q < qd) pre += t; }
        unsigned kk[8];
#pragma unroll
        for (int i = 0; i < 8; ++i) {
            const float b0 = bs[2 * i] + pre, b1 = bs[2 * i + 1] + pre;
            const float k0 = (1.0f - __expf(lf[2 * i])) * __expf(total - b0), k1 = (1.0f - __expf(lf[2 * i + 1])) * __expf(total - b1);
            kk[i] = pk2(k0, k1);
        }
        *(LAS v4u*)(KT + c * KT_P + 16 * qd) = (v4u){kk[0], kk[1], kk[2], kk[3]};
        *(LAS v4u*)(KT + c * KT_P + 16 * qd + 8) = (v4u){kk[4], kk[5], kk[6], kk[7]};
        *(LAS v4u*)(VT + c * KT_P + 16 * qd) = (v4u){vv[0], vv[1], vv[2], vv[3]};
        *(LAS v4u*)(VT + c * KT_P + 16 * qd + 8) = (v4u){vv[4], vv[5], vv[6], vv[7]};
        if (qd == 3) DEC[(size_t)unit * 128 + c] = __expf(total);
        __syncthreads();
        const bf16x8 a0 = *(const LAS bf16x8*)(KT + (16 * w + l16) * KT_P + 8 * lq), a1 = *(const LAS bf16x8*)(KT + (16 * w + l16) * KT_P + 8 * lq + 32);
#pragma unroll
        for (int vb = 0; vb < 8; ++vb) {
            const bf16x8 b0 = *(const LAS bf16x8*)(VT + (16 * vb + l16) * KT_P + 8 * lq), b1 = *(const LAS bf16x8*)(VT + (16 * vb + l16) * KT_P + 8 * lq + 32);
            f32x4 acc = (f32x4){0.f, 0.f, 0.f, 0.f};
            acc = __builtin_amdgcn_mfma_f32_16x16x32_bf16(a0, b0, acc, 0, 0, 0);
            acc = __builtin_amdgcn_mfma_f32_16x16x32_bf16(a1, b1, acc, 0, 0, 0);
            v2u o; o.x = pk2(acc[0], acc[1]); o.y = pk2(acc[2], acc[3]);
            *(v2u*)(U + ((size_t)unit * 128 + 16 * vb + l16) * 128 + 16 * w + 4 * lq) = o;
        }
    }
    __syncthreads();
}
__device__ __forceinline__ void phase_hg_scan(Frame& F) {
    bf16* U = (bf16*)(F.ws + WS_U); const float* DEC = (const float*)(F.ws + WS_DEC);
    for (int it = F.bid * NTHR + F.tid; it < 32 * 128 * 32; it += F.G * NTHR) {
        const int bh = it >> 12, v = (it >> 5) & 127, k4 = (it & 31) * 4;
        bf16* up = U + ((size_t)(bh * 64) * 128 + v) * 128 + k4;
        const float* dp = DEC + (size_t)(bh * 64) * 128 + k4;
        float S0 = 0.f, S1 = 0.f, S2 = 0.f, S3 = 0.f;
        for (int cb = 0; cb < 64; cb += 8) {
            v2u uu[8]; f32x4 dd[8];
#pragma unroll
            for (int j = 0; j < 8; ++j) { uu[j] = *(const v2u*)(up + (size_t)(cb + j) * 16384); dd[j] = *(const f32x4*)(dp + (cb + j) * 128); }
#pragma unroll
            for (int j = 0; j < 8; ++j) {
                v2u o; o.x = pk2(S0, S1); o.y = pk2(S2, S3);
                *(v2u*)(up + (size_t)(cb + j) * 16384) = o;
                S0 = dd[j][0] * S0 + bflo(uu[j].x); S1 = dd[j][1] * S1 + bfhi(uu[j].x); S2 = dd[j][2] * S2 + bflo(uu[j].y); S3 = dd[j][3] * S3 + bfhi(uu[j].y);
            }
        }
    }
}
__device__ __forceinline__ void phase_hg_out(Frame& F) {
    LAS float* Bf = (LAS float*)F.lds;
    LAS float* tot = (LAS float*)(F.lds + 32768);
    LAS bf16* Qs = (LAS bf16*)(F.lds + 34816);
    LAS bf16* Ks = (LAS bf16*)(F.lds + 52224);
    LAS bf16* VT = (LAS bf16*)(F.lds + 69632);
    LAS bf16* Sc = (LAS bf16*)(F.lds + 88064);
    LAS float* part = (LAS float*)(F.lds + 97280);
    const float* Fl = (const float*)(F.ws + WS_F); const bf16* V = (const bf16*)(F.ws + WS_V); const bf16* G = (const bf16*)(F.ws + WS_G);
    bf16* Q = (bf16*)(F.ws + WS_Q); const bf16* U = (const bf16*)(F.ws + WS_U); const float* gn = F.in[14];
    const int tid = F.tid, lane = F.lane, w = F.wave, c = tid & 127, qd = tid >> 7, l16 = lane & 15, lq = lane >> 4;
    for (int unit = F.bid; unit < 2048; unit += F.G) {
        const int bh = unit >> 6, chunk = unit & 63, b = bh >> 3, h = bh & 7;
        const size_t m0 = (size_t)b * T + chunk * 64; const int c0 = h * 128;
        __syncthreads();
        for (int e = tid; e < 2048; e += NTHR) { const int s = e >> 5, c4 = e & 31;
            *(LAS f32x4*)(Bf + s * 128 + c4 * 4) = *(const f32x4*)(Fl + (m0 + s) * D + c0 + c4 * 4); }
        unsigned vv[8], qq[8];
#pragma unroll
        for (int i = 0; i < 8; ++i) {
            const size_t o0 = (m0 + 16 * qd + 2 * i) * D + c0 + c, o1 = o0 + D;
            vv[i] = (unsigned)V[o0] | ((unsigned)V[o1] << 16); qq[i] = (unsigned)Q[o0] | ((unsigned)Q[o1] << 16);
        }
        bf16x8 st[4];
#pragma unroll
        for (int kk = 0; kk < 4; ++kk) st[kk] = *(const bf16x8*)(U + ((size_t)unit * 128 + 16 * w + l16) * 128 + 8 * lq + 32 * kk);
        __syncthreads();
        float lf[16], bs[16]; float run = 0.f;
#pragma unroll
        for (int i = 0; i < 16; ++i) { lf[i] = Bf[(16 * qd + i) * 128 + c]; run += lf[i]; bs[i] = run; }
        tot[qd * 128 + c] = run;
        __syncthreads();
        float pre = 0.f;
#pragma unroll
        for (int q = 0; q < 4; ++q) { const float t = tot[q * 128 + c]; if (q < qd) pre += t; }
#pragma unroll
        for (int i = 0; i < 16; ++i) {
            const float bb = bs[i] + pre;
            const float qv = ((i & 1) ? bfhi(qq[i >> 1]) : bflo(qq[i >> 1])) * __expf(bb);
            const float kv = (1.0f - __expf(lf[i])) * __expf(-bb);
            const unsigned pq = pk2(qv, kv);
            Qs[(16 * qd + i) * QS_P + c] = (bf16)(pq & 0xffffu);
            Ks[(16 * qd + i) * QS_P + c] = (bf16)(pq >> 16);
        }
        *(LAS v4u*)(VT + c * KT_P + 16 * qd) = (v4u){vv[0], vv[1], vv[2], vv[3]};
        *(LAS v4u*)(VT + c * KT_P + 16 * qd + 8) = (v4u){vv[4], vv[5], vv[6], vv[7]};
        __syncthreads();
        {
            const int tb = w >> 1;
            bf16x8 qf[4];
#pragma unroll
            for (int kk = 0; kk < 4; ++kk) qf[kk] = *(const LAS bf16x8*)(Qs + (16 * tb + l16) * QS_P + 8 * lq + 32 * kk);
#pragma unroll
            for (int j = 0; j < 2; ++j) {
                const int sb = 2 * (w & 1) + j;
                f32x4 acc = (f32x4){0.f, 0.f, 0.f, 0.f};
                if (sb <= tb) {
#pragma unroll
                    for (int kk = 0; kk < 4; ++kk) { const bf16x8 kf = *(const LAS bf16x8*)(Ks + (16 * sb + l16) * QS_P + 8 * lq + 32 * kk);
                        acc = __builtin_amdgcn_mfma_f32_16x16x32_bf16(kf, qf[kk], acc, 0, 0, 0); }
                    const int t = 16 * tb + l16, s0 = 16 * sb + 4 * lq;
#pragma unroll
                    for (int i = 0; i < 4; ++i) if (s0 + i > t) acc[i] = 0.f;
                }
                v2u o; o.x = pk2(acc[0], acc[1]); o.y = pk2(acc[2], acc[3]);
                *(LAS v2u*)(Sc + (16 * tb + l16) * KT_P + 16 * sb + 4 * lq) = o;
            }
        }
        __syncthreads();
        f32x4 oacc[4];
        {
            const bf16x8 vf0 = *(const LAS bf16x8*)(VT + (16 * w + l16) * KT_P + 8 * lq), vf1 = *(const LAS bf16x8*)(VT + (16 * w + l16) * KT_P + 8 * lq + 32);
#pragma unroll
            for (int tb = 0; tb < 4; ++tb) {
                f32x4 acc = (f32x4){0.f, 0.f, 0.f, 0.f};
#pragma unroll
                for (int kk = 0; kk < 4; ++kk) { const bf16x8 qf = *(const LAS bf16x8*)(Qs + (16 * tb + l16) * QS_P + 8 * lq + 32 * kk);
                    acc = __builtin_amdgcn_mfma_f32_16x16x32_bf16(st[kk], qf, acc, 0, 0, 0); }
                const bf16x8 s0 = *(const LAS bf16x8*)(Sc + (16 * tb + l16) * KT_P + 8 * lq), s1 = *(const LAS bf16x8*)(Sc + (16 * tb + l16) * KT_P + 8 * lq + 32);
                acc = __builtin_amdgcn_mfma_f32_16x16x32_bf16(vf0, s0, acc, 0, 0, 0);
                acc = __builtin_amdgcn_mfma_f32_16x16x32_bf16(vf1, s1, acc, 0, 0, 0);
                oacc[tb] = acc;
                float p = (acc[0] * acc[0] + acc[1] * acc[1]) + (acc[2] * acc[2] + acc[3] * acc[3]);
                p += __shfl_xor(p, 16); p += __shfl_xor(p, 32);
                if (lane < 16) part[w * 64 + 16 * tb + lane] = p;
            }
        }
        __syncthreads();
        {
            const f32x4 gv = *(const f32x4*)(gn + c0 + 16 * w + 4 * lq);
#pragma unroll
            for (int tb = 0; tb < 4; ++tb) {
                const int t = 16 * tb + l16;
                float s = 0.f;
#pragma unroll
                for (int ww = 0; ww < 8; ++ww) s += part[ww * 64 + t];
                const float rstd = rsqrtf(s * (1.0f / 128.0f) + EPS);
                const size_t off = (m0 + t) * D + c0 + 16 * w + 4 * lq;
                const v2u gg = *(const v2u*)(G + off);
                v2u o; o.x = pk2(oacc[tb][0] * rstd * gv[0] * bflo(gg.x), oacc[tb][1] * rstd * gv[1] * bfhi(gg.x));
                o.y = pk2(oacc[tb][2] * rstd * gv[2] * bflo(gg.y), oacc[tb][3] * rstd * gv[3] * bfhi(gg.y));
                *(v2u*)(Q + off) = o;
            }
        }
    }
    __syncthreads();
}
__device__ __forceinline__ void phase_final(Frame& F) {
    const float* ss = (const float*)(F.ws + WS_SS) + 4 * SSN; const float* fg = F.in[3];
    const int gw = F.bid * NWAVES + F.wave, NGW = F.G * NWAVES;
    f32x4 g[4];
#pragma unroll
    for (int j = 0; j < 4; ++j) g[j] = *((const f32x4*)fg + F.lane + 64 * j);
    for (int m = gw; m < M; m += NGW) {
        const float rs = row_rstd(ss, m);
        f32x4* xr = (f32x4*)(F.out + (size_t)m * D) + F.lane;
#pragma unroll
        for (int j = 0; j < 4; ++j) { f32x4 v = xr[64 * j]; v = v * rs * g[j]; xr[64 * j] = v; }
    }
}


#ifdef STOP_AFTER
__device__ __forceinline__ void dbg_dump(Frame& F, int k) {
    unsigned char* ws = F.ws;
    for (size_t i = (size_t)F.bid * NTHR + F.tid; i < (size_t)M * D; i += (size_t)F.G * NTHR) {
        const size_t m = i >> 10; const int c = (int)(i & 1023);
        float v = 0.f;
        if (k == 0) v = __uint_as_float((unsigned)((const bf16*)(ws + WS_HB))[i] << 16) + ((const float*)(ws + WS_SS))[m] * 1e-3f + __uint_as_float((unsigned)((const bf16*)(ws + WS_UP1))[i] << 16) + __uint_as_float((unsigned)((const bf16*)(ws + WS_HGIN))[i] << 16);
        else if (k == 1) v = c < 512 ? __uint_as_float((unsigned)((const bf16*)(ws + WS_AG))[m * 512 + c] << 16) : __uint_as_float((unsigned)((const bf16*)(ws + WS_UU))[m * 512 + c - 512] << 16);
        else if (k == 2) v = c < 512 ? __uint_as_float((unsigned)((const bf16*)(ws + WS_CAT))[m * 1024 + c] << 16) : __uint_as_float((unsigned)((const bf16*)(ws + WS_DD))[m * 512 + c - 512] << 16);
        else if (k == 3) v = __uint_as_float((unsigned)((const bf16*)(ws + WS_CAT))[i] << 16);
        else if (k == 4) v = F.out[i] + __uint_as_float((unsigned)((const bf16*)(ws + WS_HB))[i] << 16) + ((const float*)(ws + WS_SS))[M + m] * 1e-3f;
        else if (k == 5) v = __uint_as_float((unsigned)((const bf16*)(ws + WS_HID))[m * FF + c] << 16) + __uint_as_float((unsigned)((const bf16*)(ws + WS_HID))[m * FF + 1024 + c] << 16) + __uint_as_float((unsigned)((const bf16*)(ws + WS_HID))[m * FF + 1792 + c] << 16);
        else if (k == 6) v = F.out[i];
        else if (k == 7) v = __uint_as_float((unsigned)((const bf16*)(ws + WS_Q))[i] << 16) + ((const float*)(ws + WS_F))[i] + __uint_as_float((unsigned)((const bf16*)(ws + WS_V))[i] << 16) + __uint_as_float((unsigned)((const bf16*)(ws + WS_G))[i] << 16);
        else if (k == 8 || k == 9) v = __uint_as_float((unsigned)((const bf16*)(ws + WS_U))[i] << 16) + __uint_as_float((unsigned)((const bf16*)(ws + WS_U))[i + (size_t)M * D] << 16) + ((const float*)(ws + WS_DEC))[i & 262143];
        else if (k == 10) v = __uint_as_float((unsigned)((const bf16*)(ws + WS_Q))[i] << 16);
        else v = F.out[i];
        F.out[i] = v;
    }
}
#define DBG_STOP(k) do { if (STOP_AFTER == (k)) { if ((k) == 4 || (k) == 6 || (k) >= 11) {   } dbg_dump(F, (k)); return; } } while (0)
#else
#define DBG_STOP(k) do { } while (0)
#endif
#define GEMM_PHASE(EPI, Aptr, Bptr, NN, KK, E) do { pg8::Gemm g_{(const pg8::bf16_t*)(Aptr), (const pg8::bf16_t*)(Bptr), M, (NN), (KK)}; pg8::StaticOrder S_; S_.init(M, (NN), F.G, F.bid); \
        pg8::gemm_phase<EPI, pg8::StaticOrder, true, true>(F.lds, g_, S_, (E)); } while (0)

__global__ void __launch_bounds__(NTHR, 2) trunk_fwd(Args args) {
    extern __shared__ __attribute__((aligned(16))) unsigned char lds_raw[];
    Frame F;
    F.lds = (LAS unsigned char*)lds_raw;
    F.tid = threadIdx.x; F.lane = F.tid & 63; F.wave = __builtin_amdgcn_readfirstlane(F.tid >> 6);
    F.G = gridDim.x; F.bid = blockIdx.x;
    F.in = args.in; F.out = args.out; F.ws = args.ws;
    unsigned char* ws = args.ws;
    float* ss = (float*)(ws + WS_SS);
    bf16* HB = (bf16*)args.out;
    bf16* HB1 = (bf16*)(ws + WS_HB);

    for (int u = F.tid; u < (LDS_BYTES - LDSCTL_OFF) / 4; u += NTHR) ((LAS unsigned*)(F.lds + LDSCTL_OFF))[u] = 0u;
    __syncthreads();
    XcdBarrier bar = xcd_barrier_post((unsigned*)(ws + WS_CTL), (volatile LAS unsigned*)(F.lds + MISC_OFF) + 8);
    cg::this_grid().sync();
#define GRID_SYNC() xcd_barrier(bar)
#if !defined(PHMASK) || (PHMASK & (1 << 0))
    p0_prologue(F);
#endif
    GRID_SYNC();
    DBG_STOP(0);
#if !defined(PHMASK) || (PHMASK & (1 << 1))
    { EpiInCP E{(bf16*)(ws + WS_AG), (bf16*)(ws + WS_UU), ss}; GEMM_PHASE(EpiInCP, HB, ws + WS_WIN0, NIN0, D, E); }
#endif
    GRID_SYNC();
    DBG_STOP(1);
#if !defined(PHMASK) || (PHMASK & (1 << 2))
    phase_convpool(F);
#endif
    GRID_SYNC();
    DBG_STOP(2);
#if !defined(PHMASK) || (PHMASK & (1 << 4))
    { EpiResid E{HB, HB, nullptr, ss + SSN}; GEMM_PHASE(EpiResid, ws + WS_CAT, ws + WS_WOUT0, D, D, E); }
#endif
    GRID_SYNC();
    DBG_STOP(4);
#if !defined(PHMASK) || (PHMASK & (1 << 5))
    { EpiSwiGLU E{(bf16*)(ws + WS_HID), ss + SSN}; GEMM_PHASE(EpiSwiGLU, HB, ws + WS_UP0, NUP, D, E); }
#endif
    GRID_SYNC();
    DBG_STOP(5);
#if !defined(PHMASK) || (PHMASK & (1 << 6))
    { EpiResid E{HB, HB, nullptr, ss + 2 * SSN}; GEMM_PHASE(EpiResid, ws + WS_HID, ws + WS_DN0, D, FF, E); }
#endif
    GRID_SYNC();
    DBG_STOP(6);
#if !defined(PHMASK) || (PHMASK & (1 << 7))
    { EpiHgIn E{(bf16*)(ws + WS_Q), (float*)(ws + WS_F), (bf16*)(ws + WS_V), (bf16*)(ws + WS_G), ss + 2 * SSN, F.in[13]}; GEMM_PHASE(EpiHgIn, HB, ws + WS_HGIN, NHG, D, E); }
#endif
    GRID_SYNC();
    DBG_STOP(7);
#if !defined(PHMASK) || (PHMASK & (1 << 8))
    phase_hg_state(F);
#endif
    GRID_SYNC();
    DBG_STOP(8);
#if !defined(PHMASK) || (PHMASK & (1 << 9))
    phase_hg_scan(F);
#endif
    GRID_SYNC();
    DBG_STOP(9);
#if !defined(PHMASK) || (PHMASK & (1 << 10))
    phase_hg_out(F);
#endif
    GRID_SYNC();
    DBG_STOP(10);
#if !defined(PHMASK) || (PHMASK & (1 << 11))
    { EpiResid E{HB, HB1, nullptr, ss + 3 * SSN}; GEMM_PHASE(EpiResid, ws + WS_Q, ws + WS_HGOUT, D, D, E); }
#endif
    GRID_SYNC();
    DBG_STOP(11);
#if !defined(PHMASK) || (PHMASK & (1 << 12))
    { EpiSwiGLU E{(bf16*)(ws + WS_HID), ss + 3 * SSN}; GEMM_PHASE(EpiSwiGLU, HB1, ws + WS_UP1, NUP, D, E); }
#endif
    GRID_SYNC();
    DBG_STOP(12);
#if !defined(PHMASK) || (PHMASK & (1 << 13))
    { EpiResid E{HB1, nullptr, F.out, ss + 4 * SSN}; GEMM_PHASE(EpiResid, ws + WS_HID, ws + WS_DN1, D, FF, E); }
#endif
    GRID_SYNC();
    DBG_STOP(13);
#if !defined(PHMASK) || (PHMASK & (1 << 14))
    phase_final(F);
#endif
}

extern "C" void kernel_launch(void* const* d_in, const int* in_sizes, int n_in, void* d_out, int out_size, void* d_ws, size_t ws_size, hipStream_t stream) {
    static int grid = 0;
    if (grid == 0) {
        if (n_in != 19 || out_size != M * D || ws_size < WS_END) { fprintf(stderr, "kernel_launch: unexpected shapes (n_in %d out %d ws %zu)\n", n_in, out_size, ws_size); grid = -1; return; }
        int dev = 0, cus = 0, per_cu = 0;
        (void)hipGetDevice(&dev);
        (void)hipDeviceGetAttribute(&cus, hipDeviceAttributeMultiprocessorCount, dev);
        if (hipFuncSetAttribute((const void*)trunk_fwd, hipFuncAttributeMaxDynamicSharedMemorySize, LDS_BYTES) != hipSuccess) { fprintf(stderr, "kernel_launch: hipFuncSetAttribute failed\n"); grid = -1; return; }
        if (hipOccupancyMaxActiveBlocksPerMultiprocessor(&per_cu, (const void*)trunk_fwd, NTHR, LDS_BYTES) != hipSuccess || per_cu < 1) { fprintf(stderr, "kernel_launch: occupancy query says %d\n", per_cu); per_cu = 1; }
        (void)hipGetLastError();
        grid = cus * 1;
        if (grid > cus * per_cu) grid = cus * per_cu;
        fprintf(stderr, "kernel_launch: grid %d (cus %d, per_cu %d)\n", grid, cus, per_cu);
    }
    if (grid < 0) return;
    if (hipMemsetAsync((char*)d_ws + WS_CTL, 0, CTL_ZERO_BYTES, stream) != hipSuccess) { fprintf(stderr, "kernel_launch: memset failed\n"); return; }
    Args a{};
    for (int i = 0; i < 19; ++i) a.in[i] = (const float*)d_in[i];
    a.out = (float*)d_out; a.ws = (unsigned char*)d_ws;
    void* kargs[] = {&a};
    hipError_t e = hipLaunchCooperativeKernel((const void*)trunk_fwd, dim3(grid), dim3(NTHR), kargs, LDS_BYTES, stream);
    if (e != hipSuccess) fprintf(stderr, "kernel_launch: cooperative launch failed: %s (grid %d)\n", hipGetErrorString(e), grid);
}
```

```cpp
#include <hip/hip_runtime.h>
#include <hip/hip_cooperative_groups.h>
#include <cstdio>
#include <cstdint>
namespace cg = cooperative_groups;
namespace pg8 {
#define PG8_LAS __attribute__((address_space(3)))
typedef unsigned short bf16_t;
typedef short bf16x8 __attribute__((ext_vector_type(8)));
typedef float f32x4 __attribute__((ext_vector_type(4)));
typedef unsigned u32x4 __attribute__((ext_vector_type(4)));
constexpr int BM = 256, BK = 64, HALF = 128, HTB = HALF * BK * 2  , STAGE_BYTES = 8 * HTB, NXCD = 8, WGM = 8;

__host__ __device__ __forceinline__ int lds_byte(int r, int c) { const int st = (r >> 4) * 2 + (c >> 5), rr = r & 15, cc = c & 31, ob = rr * 64 + cc * 2; return st * 1024 + (ob ^ (((ob >> 9) & 1) << 5)); }
__host__ __device__ __forceinline__ void stage_rc(int b, int& R, int& C) { const int st = b / 1024, sb = b % 1024, swz = sb ^ (((sb >> 9) & 1) << 5); R = (st >> 1) * 16 + swz / 64; C = (st & 1) * 32 + (swz % 64) / 2; }
__host__ __device__ __forceinline__ int perm32(int rho) { const int n = rho >> 4, i = rho & 15; return 8 * (i >> 2) + 4 * n + (i & 3); }

struct Unit { int pm, pn; };
struct Gemm { const bf16_t* A; const bf16_t* Bt; int M, N, K; };

struct StaticOrder {
    int nM, nN, nwg, G, c;
    __host__ __device__ void init(int M, int N, int G_, int c_) { nM = M / BM; nN = N / BM; nwg = nM * nN; G = G_; c = c_; }
    __host__ __device__ bool next(int i, Unit& u) const {
        const long L = (long)i * G + c; if (L >= nwg) return false;
        int wgid = (int)L; { const int q = nwg / NXCD, r = nwg % NXCD, xcd = wgid % NXCD, off = wgid / NXCD; wgid = (xcd < r ? xcd * (q + 1) : r * (q + 1) + (xcd - r) * q) + off; }
        const int nig = WGM * nN, gid = wgid / nig, fm = gid * WGM, gsz = (nM - fm) < WGM ? (nM - fm) : WGM;
        u.pm = fm + ((wgid % nig) % gsz); u.pn = (wgid % nig) / gsz; return true;
    }
    __device__ __forceinline__ void a_ready(const Unit&) const {}
    __device__ __forceinline__ void done(const Unit&) const {}
};

__device__ __forceinline__ unsigned cvt_pk_bf16(float lo, float hi) { unsigned r; asm volatile("v_cvt_pk_bf16_f32 %0, %1, %2" : "=v"(r) : "v"(lo), "v"(hi)); return r; }
template <class Epi, class Sched, bool ALIGN_EPI = false, bool SP2 = false>
__device__ __forceinline__ void gemm_phase(PG8_LAS unsigned char* lds, const Gemm g, const Sched& S, const Epi& E) {
    const int tid = threadIdx.x, wid = __builtin_amdgcn_readfirstlane(tid >> 6), lane = tid & 63, wr = wid >> 2, wc = wid & 3, fr = lane & 15, fq = lane >> 4;
    const int K = g.K, nt = K / BK;
    unsigned voffA[2], voffB[2];
#pragma unroll
    for (int i = 0; i < 2; ++i) { int R, C; stage_rc(tid * 16 + i * 8192, R, C); const int Rb = Epi::PERM ? ((R & ~31) + perm32(R & 31)) : R;
        voffA[i] = (unsigned)(R * K + C) * 2u; voffB[i] = (unsigned)(Rb * K + C) * 2u; }
    const size_t kstep = (size_t)(BK * 2);
    const size_t hstep = (size_t)HALF * K * 2;
    const size_t tstep = 2 * hstep;
    const unsigned ldsw = (unsigned)wid * 1024u;
    const int aoff = lds_byte(wr * 64 + fr, fq * 8), boff = lds_byte(wc * 32 + fr, fq * 8);
#define PG8_SA(b, h) (((b) * 2 + (h)) * HTB)
#define PG8_SB(b, h) ((4 + (b) * 2 + (h)) * HTB)
#define PG8_STAGE(bufoff, gbase, voff) do { _Pragma("unroll") for (int _i = 0; _i < 2; ++_i) \
        __builtin_amdgcn_global_load_lds((const unsigned*)((const char*)(gbase) + (voff)[_i]), (PG8_LAS unsigned*)(lds + (bufoff) + ldsw + _i * 8192), 16, 0, 0); } while (0)
#define PG8_LDA(dst, b, h) do { _Pragma("unroll") for (int m = 0; m < 4; ++m) _Pragma("unroll") for (int k = 0; k < 2; ++k) dst[m][k] = *(const PG8_LAS bf16x8*)(lds + PG8_SA(b, h) + aoff + m * 2048 + k * 1024); } while (0)
#define PG8_LDB(dst, b, h) do { _Pragma("unroll") for (int n = 0; n < 2; ++n) _Pragma("unroll") for (int k = 0; k < 2; ++k) dst[n][k] = *(const PG8_LAS bf16x8*)(lds + PG8_SB(b, h) + boff + n * 2048 + k * 1024); } while (0)
#define PG8_MMA(ai, bj, At, Bt) do { __builtin_amdgcn_s_setprio(1); _Pragma("unroll") for (int m = 0; m < 4; ++m) _Pragma("unroll") for (int n = 0; n < 2; ++n) _Pragma("unroll") for (int k = 0; k < 2; ++k) \
        acc[ai][bj][m][n] = __builtin_amdgcn_mfma_f32_16x16x32_bf16(Bt[n][k], At[m][k], acc[ai][bj][m][n], 0, 0, 0); __builtin_amdgcn_s_setprio(0); } while (0)
#define PG8_WAIT_V(n) asm volatile("s_waitcnt vmcnt(" #n ")" ::: "memory")
#define PG8_WAIT_L(n) asm volatile("s_waitcnt lgkmcnt(" #n ")" ::: "memory")
#define PG8_BAR __builtin_amdgcn_s_barrier()
#define PG8_SCHED __builtin_amdgcn_sched_barrier(0)
    Unit cur, nxt; int ui = 0;
    if (!S.next(0, cur)) return;
    f32x4 acc[2][2][4][2];
#pragma unroll
    for (int a = 0; a < 2; ++a)
#pragma unroll
        for (int b = 0; b < 2; ++b)
#pragma unroll
            for (int m = 0; m < 4; ++m)
#pragma unroll
                for (int n = 0; n < 2; ++n) acc[a][b][m][n] = (f32x4){0.f, 0.f, 0.f, 0.f};
    bf16x8 At[4][2], B0[2][2], B1[2][2];
    const char* cA = (const char*)g.A + (size_t)cur.pm * tstep; const char* cB = (const char*)g.Bt + (size_t)cur.pn * tstep;
    S.a_ready(cur);
    if constexpr (SP2) {
        PG8_STAGE(PG8_SB(0, 0), cB, voffB); PG8_STAGE(PG8_SB(0, 1), cB + hstep, voffB); PG8_STAGE(PG8_SA(0, 0), cA, voffA); PG8_STAGE(PG8_SA(0, 1), cA + hstep, voffA);
        if (wr == 1) PG8_BAR;
        PG8_WAIT_V(2); PG8_BAR;
        PG8_STAGE(PG8_SB(1, 0), cB + kstep, voffB); PG8_STAGE(PG8_SA(1, 0), cA + kstep, voffA); PG8_STAGE(PG8_SB(1, 1), cB + hstep + kstep, voffB);
        PG8_WAIT_V(6); PG8_BAR;
    } else {
        PG8_STAGE(PG8_SB(0, 0), cB, voffB); PG8_STAGE(PG8_SA(0, 0), cA, voffA); PG8_STAGE(PG8_SB(0, 1), cB + hstep, voffB); PG8_STAGE(PG8_SA(0, 1), cA + hstep, voffA);
        if (wr == 1) PG8_BAR;
        PG8_WAIT_V(4); PG8_BAR;
        PG8_STAGE(PG8_SB(1, 0), cB + kstep, voffB); PG8_STAGE(PG8_SA(1, 0), cA + kstep, voffA); PG8_STAGE(PG8_SB(1, 1), cB + hstep + kstep, voffB);
        PG8_WAIT_V(6); PG8_BAR;
    }
    for (;;) {
        const bool has_next = S.next(ui + 1, nxt);
        const char* nA = has_next ? (const char*)g.A + (size_t)nxt.pm * tstep : cA; const char* nB = has_next ? (const char*)g.Bt + (size_t)nxt.pn * tstep : cB;
        for (int t = 0; t < nt; t += 2) {
            const bool last = (t == nt - 2);
            const char* a1 = cA + (size_t)(t + 1) * kstep;
            const char* a2 = last ? nA : cA + (size_t)(t + 2) * kstep; const char* b2 = last ? nB : cB + (size_t)(t + 2) * kstep;
            const char* a3 = a2 + kstep; const char* b3 = b2 + kstep;
            if (last && has_next) S.a_ready(nxt);
            if constexpr (SP2) {
            PG8_LDB(B0, 0, 0); PG8_LDB(B1, 0, 1); PG8_SCHED; PG8_LDA(At, 0, 0); PG8_STAGE(PG8_SA(1, 1), a1 + hstep, voffA);
            PG8_WAIT_V(8); PG8_WAIT_L(0); PG8_BAR; PG8_MMA(0, 0, At, B0); PG8_MMA(0, 1, At, B1); PG8_BAR; PG8_SCHED;
            PG8_LDA(At, 0, 1); PG8_STAGE(PG8_SB(0, 0), b2, voffB); PG8_STAGE(PG8_SB(0, 1), b2 + hstep, voffB); PG8_STAGE(PG8_SA(0, 0), a2, voffA);
            PG8_WAIT_V(8); PG8_WAIT_L(0); PG8_BAR; PG8_MMA(1, 0, At, B0); PG8_MMA(1, 1, At, B1); PG8_BAR; PG8_SCHED;
            PG8_LDB(B0, 1, 0); PG8_LDB(B1, 1, 1); PG8_SCHED; PG8_LDA(At, 1, 0); PG8_STAGE(PG8_SA(0, 1), a2 + hstep, voffA);
            PG8_WAIT_V(8); PG8_WAIT_L(0); PG8_BAR; PG8_MMA(0, 0, At, B0); PG8_MMA(0, 1, At, B1); PG8_BAR; PG8_SCHED;
            PG8_LDA(At, 1, 1); PG8_STAGE(PG8_SB(1, 0), b3, voffB); PG8_STAGE(PG8_SB(1, 1), b3 + hstep, voffB); PG8_STAGE(PG8_SA(1, 0), a3, voffA);
            PG8_WAIT_V(8); PG8_WAIT_L(0); PG8_BAR; PG8_MMA(1, 0, At, B0); PG8_MMA(1, 1, At, B1); PG8_BAR; PG8_SCHED;
            } else {
            PG8_LDB(B0, 0, 0); PG8_SCHED; PG8_LDA(At, 0, 0); PG8_STAGE(PG8_SA(1, 1), a1 + hstep, voffA);
            PG8_WAIT_L(8); PG8_BAR; PG8_WAIT_L(0); PG8_MMA(0, 0, At, B0); PG8_BAR; PG8_SCHED;
            PG8_LDB(B1, 0, 1); PG8_STAGE(PG8_SB(0, 0), b2, voffB);
            PG8_BAR; PG8_WAIT_L(0); PG8_MMA(0, 1, At, B1); PG8_BAR;
            PG8_LDA(At, 0, 1); PG8_STAGE(PG8_SA(0, 0), a2, voffA);
            PG8_BAR; PG8_WAIT_L(0); PG8_MMA(1, 0, At, B0); PG8_BAR; PG8_SCHED;
            PG8_STAGE(PG8_SB(0, 1), b2 + hstep, voffB);
            PG8_WAIT_V(6); PG8_BAR; PG8_MMA(1, 1, At, B1); PG8_BAR;
            PG8_LDB(B0, 1, 0); PG8_SCHED; PG8_LDA(At, 1, 0); PG8_STAGE(PG8_SA(0, 1), a2 + hstep, voffA);
            PG8_WAIT_L(8); PG8_BAR; PG8_WAIT_L(0); PG8_MMA(0, 0, At, B0); PG8_BAR; PG8_SCHED;
            PG8_LDB(B1, 1, 1); PG8_STAGE(PG8_SB(1, 0), b3, voffB);
            PG8_BAR; PG8_WAIT_L(0); PG8_MMA(0, 1, At, B1); PG8_BAR;
            PG8_LDA(At, 1, 1); PG8_STAGE(PG8_SA(1, 0), a3, voffA);
            PG8_BAR; PG8_WAIT_L(0); PG8_MMA(1, 0, At, B0); PG8_BAR; PG8_SCHED;
            PG8_STAGE(PG8_SB(1, 1), b3 + hstep, voffB);
            PG8_WAIT_V(6); PG8_BAR; PG8_MMA(1, 1, At, B1); PG8_BAR;
            }
        }
        if constexpr (ALIGN_EPI) { if (wr == 0) PG8_BAR; }
        if constexpr (!Epi::AFTER_DRAIN) { E(acc, cur, wr, wc, fr, fq); S.done(cur); }
        if (!has_next) break;
#pragma unroll
        for (int a = 0; a < 2; ++a)
#pragma unroll
            for (int b = 0; b < 2; ++b)
#pragma unroll
                for (int m = 0; m < 4; ++m)
#pragma unroll
                    for (int n = 0; n < 2; ++n) acc[a][b][m][n] = (f32x4){0.f, 0.f, 0.f, 0.f};
        cur = nxt; cA = nA; cB = nB; ++ui;
        if constexpr (ALIGN_EPI) { if (wr == 1) PG8_BAR; }
    }
    PG8_WAIT_V(0);
    if constexpr (!ALIGN_EPI) { if (wr == 0) PG8_BAR; }
    PG8_BAR;
    if constexpr (Epi::AFTER_DRAIN) { E.fused(acc, cur, wr, wc, fr, fq, lds, wid, lane); S.done(cur); }
#undef PG8_SA
#undef PG8_SB
#undef PG8_STAGE
#undef PG8_LDA
#undef PG8_LDB
#undef PG8_MMA
#undef PG8_WAIT_V
#undef PG8_WAIT_L
#undef PG8_BAR
#undef PG8_SCHED
}
}

#define LAS __attribute__((address_space(3)))
typedef unsigned short bf16;
typedef unsigned v4u __attribute__((ext_vector_type(4)));
typedef unsigned v2u __attribute__((ext_vector_type(2)));
typedef float f32x4 __attribute__((ext_vector_type(4)));
typedef short bf16x8 __attribute__((ext_vector_type(8)));
constexpr int M = 16384, D = 1024, T = 4096, FF = 2816, NUP = 2 * FF, NIN0 = 1536, NHG = 4096;
constexpr float EPS = 1e-6f;
constexpr int NWAVES = 8, NTHR = 512;
constexpr int LDS_BYTES = 147456;
constexpr size_t MiB = 1u << 20;
constexpr size_t WS_WIN0 = 0, WS_WOUT0 = 3 * MiB, WS_PW = 5 * MiB, WS_UP0 = 5 * MiB + 512 * 1024, WS_DN0 = 16 * MiB + 512 * 1024, WS_HGIN = 22 * MiB;
constexpr size_t WS_HB = 30 * MiB;
constexpr size_t WS_Z = 64 * MiB;
constexpr size_t WS_AG = WS_Z, WS_UU = WS_Z + 16 * MiB, WS_CAT = WS_Z + 32 * MiB, WS_DD = WS_Z + 64 * MiB;
constexpr size_t WS_HID = WS_Z;
constexpr size_t WS_Q = WS_Z, WS_K = WS_Z + 32 * MiB, WS_V = WS_Z + 96 * MiB, WS_G = WS_Z + 128 * MiB;
static_assert(WS_G == WS_V + 32 * MiB, "EpiHgIn: g sits 32 MiB above v");
constexpr size_t WS_U = 0;
constexpr size_t WS_HGOUT = 224 * MiB, WS_UP1 = 226 * MiB, WS_DN1 = 237 * MiB;
constexpr size_t WS_SS = 246 * MiB;
constexpr size_t WS_DEC = 244 * MiB;
constexpr size_t WS_CTL = 245 * MiB, CTL_ZERO_BYTES = 64 * 1024;
constexpr size_t WS_END = 251 * MiB;
constexpr int SSN = M * 16;
constexpr int LDSCTL_OFF = 131072, MISC_OFF = LDSCTL_OFF + 320;

__device__ __forceinline__ float wave_sum(float v) {
#pragma unroll
    for (int o = 1; o < 64; o <<= 1) v += __shfl_xor(v, o);
    return v;
}
typedef float f32x2_t __attribute__((ext_vector_type(2)));
typedef __bf16 bf16x2_t __attribute__((ext_vector_type(2)));
__device__ __forceinline__ unsigned pk2(float lo, float hi) { f32x2_t v = {lo, hi}; bf16x2_t b = __builtin_convertvector(v, bf16x2_t); return __builtin_bit_cast(unsigned, b); }
__device__ __forceinline__ float bflo(unsigned w) { return __uint_as_float(w << 16); }
__device__ __forceinline__ float bfhi(unsigned w) { return __uint_as_float(w & 0xffff0000u); }
__device__ __forceinline__ float sigmoidf_(float x) { return __builtin_amdgcn_rcpf(1.0f + __expf(-x)); }
#define LDS_WAIT() asm volatile("s_waitcnt lgkmcnt(0)" ::: "memory")
__device__ __forceinline__ float row_rstd(const float* ss, int row) {
    const f32x4* p = (const f32x4*)(ss + (size_t)row * 16);
    const f32x4 a = p[0], b = p[1], c = p[2], d = p[3];
    const float s = ((a[0] + a[1]) + (a[2] + a[3])) + ((b[0] + b[1]) + (b[2] + b[3])) + (((c[0] + c[1]) + (c[2] + c[3])) + ((d[0] + d[1]) + (d[2] + d[3])));
    return rsqrtf(s * (1.0f / D) + EPS);
}

using pg8::Unit;
typedef float accf4 __attribute__((ext_vector_type(4)));

struct EpiInCP {
    static constexpr bool PERM = true, AFTER_DRAIN = false;
    bf16* AG; bf16* UU; const float* ss;
    __device__ __forceinline__ void operator()(const accf4 (&acc)[2][2][4][2], const Unit& u, int wr, int wc, int fr, int fq) const {
        const int row0 = u.pm * 256 + wr * 64 + fr;
#pragma unroll
        for (int ai = 0; ai < 2; ++ai)
#pragma unroll
            for (int m = 0; m < 4; ++m) {
                const int row = row0 + ai * 128 + m * 16;
                const float rs = row_rstd(ss, row);
                if (u.pn < 4) {
                    float o[8];
#pragma unroll
                    for (int n = 0; n < 2; ++n)
#pragma unroll
                        for (int i = 0; i < 4; ++i) { const float v = acc[ai][0][m][n][i] * rs, g = acc[ai][1][m][n][i] * rs; o[4 * n + i] = v * sigmoidf_(g); }
                    v4u w; w.x = pk2(o[0], o[1]); w.y = pk2(o[2], o[3]); w.z = pk2(o[4], o[5]); w.w = pk2(o[6], o[7]);
                    *(v4u*)(AG + (size_t)row * 512 + 128 * u.pn + 32 * wc + 8 * fq) = w;
                } else {
#pragma unroll
                    for (int bj = 0; bj < 2; ++bj) {
                        const accf4 a0 = acc[ai][bj][m][0] * rs, a1 = acc[ai][bj][m][1] * rs;
                        v4u w; w.x = pk2(a0[0], a0[1]); w.y = pk2(a0[2], a0[3]); w.z = pk2(a1[0], a1[1]); w.w = pk2(a1[2], a1[3]);
                        *(v4u*)(UU + (size_t)row * 512 + 256 * (u.pn - 4) + 128 * bj + 32 * wc + 8 * fq) = w;
                    }
                }
            }
    }
};
struct EpiPool {
    static constexpr bool PERM = true, AFTER_DRAIN = false;
    bf16* CAT; const float* scale;
    __device__ __forceinline__ void operator()(const accf4 (&acc)[2][2][4][2], const Unit& u, int wr, int wc, int fr, int fq) const {
        const int row0 = u.pm * 256 + wr * 64 + fr;
#pragma unroll
        for (int bj = 0; bj < 2; ++bj) {
            const int col = 256 * u.pn + 128 * bj + 32 * wc + 8 * fq;
            const accf4 s0 = *(const accf4*)(scale + col), s1 = *(const accf4*)(scale + col + 4);
#pragma unroll
            for (int ai = 0; ai < 2; ++ai)
#pragma unroll
                for (int m = 0; m < 4; ++m) {
                    const int row = row0 + ai * 128 + m * 16;
                    const accf4 a0 = acc[ai][bj][m][0] * s0, a1 = acc[ai][bj][m][1] * s1;
                    v4u w; w.x = pk2(a0[0], a0[1]); w.y = pk2(a0[2], a0[3]); w.z = pk2(a1[0], a1[1]); w.w = pk2(a1[2], a1[3]);
                    *(v4u*)(CAT + (size_t)row * 1024 + 512 + col) = w;
                }
        }
    }
};
struct EpiResid {
    static constexpr bool PERM = true, AFTER_DRAIN = false;
    const bf16* hbi; bf16* hbo; float* outf; float* ssn;
    __device__ __forceinline__ void operator()(const accf4 (&acc)[2][2][4][2], const Unit& u, int wr, int wc, int fr, int fq) const {
        const int row0 = u.pm * 256 + wr * 64 + fr, colb = 256 * u.pn + 32 * wc + 8 * fq;
#pragma unroll
        for (int ai = 0; ai < 2; ++ai) {
            v4u rv[4][2];
#pragma unroll
            for (int m = 0; m < 4; ++m)
#pragma unroll
                for (int bj = 0; bj < 2; ++bj) rv[m][bj] = *(const v4u*)(hbi + (size_t)(row0 + ai * 128 + m * 16) * D + colb + 128 * bj);
#pragma unroll
            for (int m = 0; m < 4; ++m) {
                const int row = row0 + ai * 128 + m * 16;
                float p = 0.f;
#pragma unroll
                for (int bj = 0; bj < 2; ++bj) {
                    const size_t off = (size_t)row * D + colb + 128 * bj;
                    const v4u r = rv[m][bj];
                    accf4 o0, o1;
                    o0[0] = bflo(r.x) + acc[ai][bj][m][0][0]; o0[1] = bfhi(r.x) + acc[ai][bj][m][0][1]; o0[2] = bflo(r.y) + acc[ai][bj][m][0][2]; o0[3] = bfhi(r.y) + acc[ai][bj][m][0][3];
                    o1[0] = bflo(r.z) + acc[ai][bj][m][1][0]; o1[1] = bfhi(r.z) + acc[ai][bj][m][1][1]; o1[2] = bflo(r.w) + acc[ai][bj][m][1][2]; o1[3] = bfhi(r.w) + acc[ai][bj][m][1][3];
                    p += (o0[0] * o0[0] + o0[1] * o0[1]) + (o0[2] * o0[2] + o0[3] * o0[3]) + (o1[0] * o1[0] + o1[1] * o1[1]) + (o1[2] * o1[2] + o1[3] * o1[3]);
                    if (outf) { *(accf4*)(outf + off) = o0; *(accf4*)(outf + off + 4) = o1; }
                    else { v4u w; w.x = pk2(o0[0], o0[1]); w.y = pk2(o0[2], o0[3]); w.z = pk2(o1[0], o1[1]); w.w = pk2(o1[2], o1[3]); *(v4u*)(hbo + off) = w; }
                }
                p += __shfl_xor(p, 16); p += __shfl_xor(p, 32);
                if (fq == 0) ssn[(size_t)row * 16 + u.pn * 4 + wc] = p;
            }
        }
    }
};
struct EpiSwiGLU {
    static constexpr bool PERM = true, AFTER_DRAIN = false;
    bf16* HID; const float* ss;
    __device__ __forceinline__ void operator()(const accf4 (&acc)[2][2][4][2], const Unit& u, int wr, int wc, int fr, int fq) const {
        const int row0 = u.pm * 256 + wr * 64 + fr;
#pragma unroll
        for (int ai = 0; ai < 2; ++ai)
#pragma unroll
            for (int m = 0; m < 4; ++m) {
                const int row = row0 + ai * 128 + m * 16;
                const float rs = row_rstd(ss, row);
                float o[8];
#pragma unroll
                for (int n = 0; n < 2; ++n)
#pragma unroll
                    for (int i = 0; i < 4; ++i) { const float a = acc[ai][0][m][n][i] * rs, b = acc[ai][1][m][n][i] * rs; o[4 * n + i] = a * sigmoidf_(a) * b; }
                v4u w; w.x = pk2(o[0], o[1]); w.y = pk2(o[2], o[3]); w.z = pk2(o[4], o[5]); w.w = pk2(o[6], o[7]);
                *(v4u*)(HID + (size_t)row * FF + 128 * u.pn + 32 * wc + 8 * fq) = w;
            }
    }
};
template <int C> __device__ __forceinline__ float dpp_row_shr(float v) { return __int_as_float(__builtin_amdgcn_update_dpp(0, __float_as_int(v), C, 0xF, 0xF, false)); }
__device__ __forceinline__ float scan16(float v) {
    v += dpp_row_shr<0x111>(v); v += dpp_row_shr<0x112>(v); v += dpp_row_shr<0x114>(v); v += dpp_row_shr<0x118>(v); return v;
}
struct EpiHgIn {
    static constexpr bool PERM = true, AFTER_DRAIN = false;
    bf16* Qt; bf16* Kt; bf16* V; bf16* G; float* DEC; const float* ss; const float* lbl;
    __device__ __forceinline__ void operator()(const accf4 (&acc)[2][2][4][2], const Unit& u, int wr, int wc, int fr, int fq) const {
        if (u.pn < 8) {
            const int h = u.pn, cb = 32 * wc + 8 * fq, lane = threadIdx.x & 63;
#pragma unroll
            for (int ai = 0; ai < 2; ++ai) {
                const int rowb = u.pm * 256 + ai * 128 + wr * 64;
                float rs[4];
#pragma unroll
                for (int m = 0; m < 4; ++m) rs[m] = row_rstd(ss, rowb + 16 * m + fr);
                const int unit = (((rowb >> 12) * 8 + h) << 6) + ((rowb & 4095) >> 6);
#pragma unroll
                for (int n = 0; n < 2; ++n) {
                    const int ch = 128 * h + cb + 4 * n;
                    float lb[4];
#pragma unroll
                    for (int i = 0; i < 4; ++i) lb[i] = 1.0f / (1.0f + expf(lbl[ch + i] - lbl[D + ch + i]));
                    float qv[4][4], kv[4][4], bv[4][4];
#pragma unroll
                    for (int m = 0; m < 4; ++m)
#pragma unroll
                        for (int i = 0; i < 4; ++i) {
                            qv[m][i] = acc[ai][0][m][n][i] * rs[m];
                            const float z = acc[ai][1][m][n][i] * rs[m];
                            const float f = lb[i] + (1.0f - lb[i]) * sigmoidf_(z);
                            kv[m][i] = 1.0f - f; bv[m][i] = logf(f);
                        }
                    float dl[4];
#pragma unroll
                    for (int i = 0; i < 4; ++i) {
                        float carry = 0.f;
#pragma unroll
                        for (int m = 0; m < 4; ++m) { const float x = scan16(bv[m][i]); const float t = __shfl(x, lane | 15); bv[m][i] = x + carry; carry += t; }
                        dl[i] = __expf(carry);
                    }
                    if (fr == 15) *(accf4*)(DEC + (size_t)unit * 128 + cb + 4 * n) = (accf4){dl[0], dl[1], dl[2], dl[3]};
#pragma unroll
                    for (int m = 0; m < 4; ++m) {
                        const size_t off = (size_t)(rowb + 16 * m + fr) * D + ch;
                        v2u wq, wk;
                        wq.x = pk2(qv[m][0] * __expf(bv[m][0]), qv[m][1] * __expf(bv[m][1])); wq.y = pk2(qv[m][2] * __expf(bv[m][2]), qv[m][3] * __expf(bv[m][3]));
                        wk.x = pk2(kv[m][0] * __expf(-bv[m][0]), kv[m][1] * __expf(-bv[m][1])); wk.y = pk2(kv[m][2] * __expf(-bv[m][2]), kv[m][3] * __expf(-bv[m][3]));
                        *(v2u*)(Qt + off) = wq; *(v2u*)(Kt + off) = wk;
                    }
                }
            }
        } else {
            const int row0 = u.pm * 256 + wr * 64 + fr, cb = 256 * (u.pn & 3) + 32 * wc + 8 * fq;
            const bool isg = u.pn >= 12;
            bf16* O = V + (isg ? (size_t)(16u << 20) : (size_t)0);
#pragma unroll
            for (int ai = 0; ai < 2; ++ai)
#pragma unroll
                for (int m = 0; m < 4; ++m) {
                    const int row = row0 + ai * 128 + m * 16;
                    const float rs = row_rstd(ss, row);
#pragma unroll
                    for (int bj = 0; bj < 2; ++bj) {
                        accf4 a0 = acc[ai][bj][m][0] * rs, a1 = acc[ai][bj][m][1] * rs;
                        if (isg) {
#pragma unroll
                            for (int i = 0; i < 4; ++i) { a0[i] = a0[i] * sigmoidf_(a0[i]); a1[i] = a1[i] * sigmoidf_(a1[i]); }
                        }
                        v4u w; w.x = pk2(a0[0], a0[1]); w.y = pk2(a0[2], a0[3]); w.z = pk2(a1[0], a1[1]); w.w = pk2(a1[2], a1[3]);
                        *(v4u*)(O + (size_t)row * D + cb + 128 * bj) = w;
                    }
                }
        }
    }
};

#define XB_TMO      128
#define XB_XCNT(j)  (256  + 64 * (j))
#define XB_XSUB(j)  (1280 + 64 * (j))
#define XB_XGEN(j)  (2304 + 64 * (j))
#define XB_TOP      3328
#define XB_TOPGEN   3392
#define XCD_BAR_WORDS 3456
#define XB_SPIN_CAP (1u << 18)

__device__ __forceinline__ unsigned xb_ld(unsigned* p)              { return __hip_atomic_load(p, __ATOMIC_RELAXED, __HIP_MEMORY_SCOPE_AGENT); }
__device__ __forceinline__ unsigned xb_add(unsigned* p, unsigned v) { return __hip_atomic_fetch_add(p, v, __ATOMIC_RELAXED, __HIP_MEMORY_SCOPE_AGENT); }
__device__ __forceinline__ unsigned xb_xcc_id() { return (unsigned)__builtin_amdgcn_s_getreg((3 << 11) | 20) & 0xFu; }
#define XB_SPIN(cond, bar) do { unsigned _sp = 0; while (cond) { __builtin_amdgcn_s_sleep(1); \
    if ((++_sp & 255u) == 0u) { if (xb_ld(&(bar)[XB_TMO])) break; if (_sp > XB_SPIN_CAP) { atomicAdd(&(bar)[XB_TMO], 1u); break; } } } } while (0)

struct XcdBarrier {
    unsigned* bar; unsigned x;
    volatile LAS unsigned* st;
};

__device__ __forceinline__ XcdBarrier xcd_barrier_post(unsigned* bar, volatile LAS unsigned* st) {
    XcdBarrier b; b.bar = bar; b.x = xb_xcc_id(); b.st = st;
    if (threadIdx.x == 0) (void)xb_add(&bar[XB_XCNT(b.x)], 1u);
    return b;
}
__device__ __forceinline__ void xcd_barrier_complete(unsigned* bar, unsigned x, unsigned& nloc, unsigned& nx) {
    const unsigned G = gridDim.x * gridDim.y * gridDim.z;
    unsigned sum, cnt, mine, sp = 0u;
    for (;;) {
        sum = 0u; cnt = 0u; mine = 0u;
#pragma unroll
        for (unsigned j = 0; j < 16; ++j) { const unsigned c = xb_ld(&bar[XB_XCNT(j)]); sum += c; cnt += (c > 0u) ? 1u : 0u; mine = (j == x) ? c : mine; }
        if (sum == G) break;
        __builtin_amdgcn_s_sleep(1);
        if ((++sp & 255u) == 0u) { if (xb_ld(&bar[XB_TMO])) break; if (sp > XB_SPIN_CAP) { atomicAdd(&bar[XB_TMO], 1u); break; } }
    }
    nloc = mine > 0u ? mine : 1u; nx = cnt > 0u ? cnt : 1u;
}

__device__ __forceinline__ void xcd_barrier(const XcdBarrier& b) {
    asm volatile("s_waitcnt vmcnt(0)" ::: "memory");
    __syncthreads();
    if (threadIdx.x == 0) {
        unsigned* bar = b.bar;
        __builtin_amdgcn_s_waitcnt(0);
        unsigned nloc = b.st[0], nx = b.st[1];
        if (nloc == 0u) { xcd_barrier_complete(bar, b.x, nloc, nx); b.st[0] = nloc; b.st[1] = nx; }
        const unsigned old = xb_add(&bar[XB_XSUB(b.x)], 1u);
        const unsigned gen = old / nloc;
        if (old + 1u == (gen + 1u) * nloc) {
            __builtin_amdgcn_fence(__ATOMIC_RELEASE, "agent");
            asm volatile("s_waitcnt vmcnt(0)" ::: "memory");
            const unsigned og = xb_add(&bar[XB_TOP], 1u);
            const unsigned tg = og / nx;
            if (og + 1u == (tg + 1u) * nx) xb_add(&bar[XB_TOPGEN], 1u);
            else XB_SPIN(xb_ld(&bar[XB_TOPGEN]) == tg, bar);
            __builtin_amdgcn_fence(__ATOMIC_ACQUIRE, "agent");
            xb_add(&bar[XB_XGEN(b.x)], 1u);
            asm volatile("s_waitcnt vmcnt(0)" ::: "memory");
        } else {
            XB_SPIN(xb_ld(&bar[XB_XGEN(b.x)]) == gen, bar);
            __builtin_amdgcn_fence(__ATOMIC_ACQUIRE, "agent");
            asm volatile("s_waitcnt vmcnt(0)" ::: "memory");
        }
    }
    __syncthreads();
}
struct Args { const float* in[19]; float* out; unsigned char* ws; };
struct Frame {
    LAS unsigned char* lds;
    int tid, lane, wave, G, bid;
    const float* const* in; float* out; unsigned char* ws;
};

__device__ __forceinline__ void tr_item(const float* W, int N, int k0, int n0, bf16* dst, int ldk, const float* g, LAS float* scr, int lane) {
    float wv[32];
#pragma unroll
    for (int i = 0; i < 32; ++i) { const int kk = 2 * i + (lane >> 5); wv[i] = W[(size_t)(k0 + kk) * N + n0 + (lane & 31)]; }
    if (g) {
#pragma unroll
        for (int i = 0; i < 32; ++i) wv[i] *= g[k0 + 2 * i + (lane >> 5)];
    }
#pragma unroll
    for (int i = 0; i < 32; ++i) scr[(2 * i + (lane >> 5)) * 33 + (lane & 31)] = wv[i];
    LDS_WAIT(); asm volatile("" ::: "memory");
    const int c = lane & 7;
#pragma unroll
    for (int j = 0; j < 4; ++j) { const int n = (lane >> 3) + 8 * j; const LAS float* s = scr + (8 * c) * 33 + n;
        v4u o; o.x = pk2(s[0 * 33], s[1 * 33]); o.y = pk2(s[2 * 33], s[3 * 33]); o.z = pk2(s[4 * 33], s[5 * 33]); o.w = pk2(s[6 * 33], s[7 * 33]);
        *(v4u*)(dst + (size_t)n * ldk + 8 * c) = o; }
    LDS_WAIT(); asm volatile("" ::: "memory");
}
__device__ __forceinline__ int map_row(int type, int n0) {
    if (type == 0) return n0;
    if (type == 1) return 256 * (n0 >> 7) + (n0 & 127);
    if (type == 2) return 256 * (n0 >> 7) + 128 + (n0 & 127);
    if (type == 4) { const int sec = n0 >> 10, wi = n0 & 1023; return sec == 0 ? 256 * (wi >> 7) + (wi & 127) : (sec == 1 ? 256 * (wi >> 7) + 128 + (wi & 127) : n0); }
    if (n0 < 512) return 256 * (n0 >> 7) + (n0 & 127);
    if (n0 < 1024) return 256 * ((n0 - 512) >> 7) + 128 + (n0 & 127);
    return n0;
}
__device__ __forceinline__ void tr_job(const float* W, int K, int N, bf16* WT, const float* g, int type, int item, LAS float* scr, int lane) {
    const int nblk = N / 32, kb = item / nblk, nb = item % nblk, k0 = 64 * kb, n0 = 32 * nb;
    tr_item(W, N, k0, n0, WT + (size_t)map_row(type, n0) * K + k0, K, g, scr, lane);
}

__device__ __forceinline__ void p0_prologue(Frame& F) {
    LAS float* scr = (LAS float*)(F.lds + F.wave * 16384);
    const int gw = F.bid * NWAVES + F.wave, NGW = F.G * NWAVES;
    unsigned char* ws = F.ws;
    constexpr int I_IN0 = 16 * 48, I_SQ = 16 * 32, I_UP = 16 * 88, I_DN = 44 * 32, I_HG = 16 * 128;
    constexpr int I_SQH = 8 * 32;
    constexpr int NITEMS = I_IN0 + I_SQH + 2 * (2 * I_UP + I_DN) + I_HG + I_SQ;
    for (int it = gw; it < NITEMS; it += NGW) {
        int r = it;
        if (r < I_IN0) { tr_job(F.in[4], D, NIN0, (bf16*)(ws + WS_WIN0), F.in[1], 3, r, scr, F.lane); continue; } r -= I_IN0;
        if (r < I_SQH) { tr_job(F.in[11], D, D, (bf16*)(ws + WS_WOUT0), nullptr, 0, r, scr, F.lane); continue; } r -= I_SQH;
        if (r < I_UP) { tr_job(F.in[16], D, FF, (bf16*)(ws + WS_UP0), F.in[2], 1, r, scr, F.lane); continue; } r -= I_UP;
        if (r < I_UP) { tr_job(F.in[17], D, FF, (bf16*)(ws + WS_UP0), F.in[2], 2, r, scr, F.lane); continue; } r -= I_UP;
        if (r < I_DN) { tr_job(F.in[18], FF, D, (bf16*)(ws + WS_DN0), nullptr, 0, r, scr, F.lane); continue; } r -= I_DN;
        if (r < I_HG) { tr_job(F.in[12], D, NHG, (bf16*)(ws + WS_HGIN), F.in[1] + D, 4, r, scr, F.lane); continue; } r -= I_HG;
        if (r < I_SQ) { tr_job(F.in[15], D, D, (bf16*)(ws + WS_HGOUT), nullptr, 0, r, scr, F.lane); continue; } r -= I_SQ;
        if (r < I_UP) { tr_job(F.in[16] + (size_t)D * FF, D, FF, (bf16*)(ws + WS_UP1), F.in[2] + D, 1, r, scr, F.lane); continue; } r -= I_UP;
        if (r < I_UP) { tr_job(F.in[17] + (size_t)D * FF, D, FF, (bf16*)(ws + WS_UP1), F.in[2] + D, 2, r, scr, F.lane); continue; } r -= I_UP;
        tr_job(F.in[18] + (size_t)D * FF, FF, D, (bf16*)(ws + WS_DN1), nullptr, 0, r, scr, F.lane);
    }
    {
        const float* pw = F.in[9]; const float* psc = F.in[10]; const float* wo = F.in[11]; bf16* WT = (bf16*)(ws + WS_WOUT0);
        for (int it = gw; it < 4 * 32 * 4; it += NGW) {
            const int g = it >> 7, cq = (it >> 2) & 31, nb = it & 3, n0 = nb * 256 + 4 * F.lane;
            f32x4 acc[4];
#pragma unroll
            for (int j = 0; j < 4; ++j) acc[j] = (f32x4){0.f, 0.f, 0.f, 0.f};
            const float* pwr = pw + (size_t)g * 16384 + (size_t)(4 * cq) * 128;
            const float* wor = wo + (size_t)(512 + 128 * g) * D + n0;
#pragma unroll 4
            for (int d = 0; d < 128; ++d) {
                const f32x4 wv = *(const f32x4*)(wor + (size_t)d * D);
                const float sc = psc[128 * g + d];
#pragma unroll
                for (int j = 0; j < 4; ++j) acc[j] += wv * (pwr[j * 128 + d] * sc);
            }
#pragma unroll
            for (int j = 0; j < 4; ++j)
#pragma unroll
                for (int i = 0; i < 4; ++i) WT[(size_t)(n0 + i) * D + 512 + 128 * g + 4 * cq + j] = (bf16)(pk2(acc[j][i], 0.f) & 0xffffu);
        }
    }
    float* ss = (float*)(ws + WS_SS);
    const float* x = F.in[0]; bf16* HB = (bf16*)F.out;
    for (int m4 = gw * 4; m4 < M; m4 += NGW * 4) {
        f32x4 v[4][4];
#pragma unroll
        for (int r = 0; r < 4; ++r) { const f32x4* xr = (const f32x4*)(x + (size_t)(m4 + r) * D) + F.lane;
#pragma unroll
            for (int j = 0; j < 4; ++j) v[r][j] = xr[64 * j]; }
#pragma unroll
        for (int r = 0; r < 4; ++r) {
            float s = 0.f;
#pragma unroll
            for (int j = 0; j < 4; ++j) s += (v[r][j][0] * v[r][j][0] + v[r][j][1] * v[r][j][1]) + (v[r][j][2] * v[r][j][2] + v[r][j][3] * v[r][j][3]);
            s = wave_sum(s);
            if (F.lane < 16) ss[(size_t)(m4 + r) * 16 + F.lane] = F.lane == 0 ? s : 0.f;
            v2u* o8 = (v2u*)(HB + (size_t)(m4 + r) * D) + F.lane;
#pragma unroll
            for (int j = 0; j < 4; ++j) { v2u w; w.x = pk2(v[r][j][0], v[r][j][1]); w.y = pk2(v[r][j][2], v[r][j][3]); o8[64 * j] = w; }
        }
    }
}

__device__ __forceinline__ void phase_convpool(Frame& F) {
    LAS float* wl = (LAS float*)F.lds;
    LAS unsigned char* at = F.lds + 63488;
    const float* dw_w = F.in[5]; const float* dw_b = F.in[6]; const float* ln_g = F.in[7]; const float* ln_b = F.in[8];
    const bf16* AG = (const bf16*)(F.ws + WS_AG); const bf16* UU = (const bf16*)(F.ws + WS_UU);
    bf16* CAT = (bf16*)(F.ws + WS_CAT);
    const int tid = F.tid, lane = F.lane, w = F.wave;
    for (int e = tid; e < 31 * 128; e += NTHR) { const int j = e >> 7, q4 = e & 127;
        const f32x4 v = *(const f32x4*)(dw_w + j * 512 + 4 * q4);
        *(LAS f32x4*)(wl + ((j * 2 + (q4 & 1)) * 64 + (q4 >> 1)) * 4) = v; }
    const int PW_ = 2 << (lane >> 4);
    for (int tile = F.bid; tile < M / 32; tile += F.G) {
        const int m0 = tile * 32, tpos0 = m0 & (T - 1);
        __syncthreads();
        for (int e = tid; e < 64 * 64; e += NTHR) { const int rr = e >> 6, ch = e & 63; v4u v = (v4u){0u, 0u, 0u, 0u};
            if (tpos0 - 30 + rr >= 0 && rr < 62) v = *(const v4u*)(AG + (size_t)(m0 - 30 + rr) * 512 + ch * 8);
            *(LAS v4u*)(at + rr * 1024 + ch * 16) = v; }
        __syncthreads();
        float acc[4][8];
        {
            const f32x4 b0 = *(const f32x4*)(dw_b + lane * 8), b1 = *(const f32x4*)(dw_b + lane * 8 + 4);
#pragma unroll
            for (int tt = 0; tt < 4; ++tt)
#pragma unroll
                for (int i = 0; i < 4; ++i) { acc[tt][i] = b0[i]; acc[tt][4 + i] = b1[i]; }
        }
        float wreg[4][8];
#pragma unroll
        for (int rr = 0; rr < 4; ++rr)
#pragma unroll
            for (int i = 0; i < 8; ++i) wreg[rr][i] = 0.f;
#pragma unroll 1
        for (int rb = 0; rb < 9; ++rb) {
#pragma unroll
            for (int rr = 0; rr < 4; ++rr) {
                const int r = 4 * rb + rr;
                const v4u av = *(const LAS v4u*)(at + (4 * w + r) * 1024 + lane * 16);
                float a[8]; a[0] = bflo(av.x); a[1] = bfhi(av.x); a[2] = bflo(av.y); a[3] = bfhi(av.y); a[4] = bflo(av.z); a[5] = bfhi(av.z); a[6] = bflo(av.w); a[7] = bfhi(av.w);
                f32x4 w0 = (f32x4){0.f, 0.f, 0.f, 0.f}, w1 = w0;
                if (r <= 30) { w0 = *(const LAS f32x4*)(wl + ((r * 2 + 0) * 64 + lane) * 4); w1 = *(const LAS f32x4*)(wl + ((r * 2 + 1) * 64 + lane) * 4); }
#pragma unroll
                for (int i = 0; i < 4; ++i) { wreg[rr][i] = w0[i]; wreg[rr][4 + i] = w1[i]; }
#pragma unroll
                for (int tt = 0; tt < 4; ++tt) {
#pragma unroll
                    for (int i = 0; i < 8; ++i) acc[tt][i] += wreg[(rr - tt) & 3][i] * a[i]; }
            }
        }
        float lg[8], lb[8];
        {
            const f32x4 g0 = *(const f32x4*)(ln_g + lane * 8), g1 = *(const f32x4*)(ln_g + lane * 8 + 4), c0 = *(const f32x4*)(ln_b + lane * 8), c1 = *(const f32x4*)(ln_b + lane * 8 + 4);
#pragma unroll
            for (int i = 0; i < 4; ++i) { lg[i] = g0[i]; lg[4 + i] = g1[i]; lb[i] = c0[i]; lb[4 + i] = c1[i]; }
        }
#pragma unroll
        for (int tt = 0; tt < 4; ++tt) {
            float s = 0.f;
#pragma unroll
            for (int i = 0; i < 8; ++i) s += acc[tt][i];
            const float mean = wave_sum(s) * (1.0f / 512.0f);
            float q = 0.f;
#pragma unroll
            for (int i = 0; i < 8; ++i) { acc[tt][i] -= mean; q += acc[tt][i] * acc[tt][i]; }
            const float rstd = rsqrtf(wave_sum(q) * (1.0f / 512.0f) + EPS);
            float o[8];
#pragma unroll
            for (int i = 0; i < 8; ++i) { const float y = acc[tt][i] * rstd * lg[i] + lb[i]; o[i] = y * sigmoidf_(y); }
            v4u wv; wv.x = pk2(o[0], o[1]); wv.y = pk2(o[2], o[3]); wv.z = pk2(o[4], o[5]); wv.w = pk2(o[6], o[7]);
            *(v4u*)(CAT + (size_t)(m0 + 4 * w + tt) * 1024 + lane * 8) = wv;
        }
        {
            const int mb = m0 + 4 * w, tb = tpos0 + 4 * w;
            float sum[4][8], self[4][8];
#pragma unroll
            for (int tt = 0; tt < 4; ++tt)
#pragma unroll
                for (int i = 0; i < 8; ++i) { sum[tt][i] = 0.f; self[tt][i] = 0.f; }
#pragma unroll
            for (int r = 0; r < 19; ++r) {
                if (tb - 15 + r < 0) continue;
                const v4u uv = *(const v4u*)(UU + (size_t)(mb - 15 + r) * 512 + lane * 8);
                float a[8]; a[0] = bflo(uv.x); a[1] = bfhi(uv.x); a[2] = bflo(uv.y); a[3] = bfhi(uv.y); a[4] = bflo(uv.z); a[5] = bfhi(uv.z); a[6] = bflo(uv.w); a[7] = bfhi(uv.w);
#pragma unroll
                for (int tt = 0; tt < 4; ++tt) { const int i_ = 15 + tt - r; if (i_ >= 0 && i_ < 16) {
                    const bool in = i_ < PW_;
#pragma unroll
                    for (int i = 0; i < 8; ++i) { sum[tt][i] += in ? a[i] : 0.f; if (i_ == 0) self[tt][i] = a[i]; } } }
            }
#pragma unroll
            for (int tt = 0; tt < 4; ++tt) {
                const int tp = tb + tt; const int cnt = (tp + 1) < PW_ ? (tp + 1) : PW_;
                const float inv = 1.0f / (float)cnt;
                float o[8];
#pragma unroll
                for (int i = 0; i < 8; ++i) o[i] = sum[tt][i] * inv - self[tt][i];
                v4u wv; wv.x = pk2(o[0], o[1]); wv.y = pk2(o[2], o[3]); wv.z = pk2(o[4], o[5]); wv.w = pk2(o[6], o[7]);
                *(v4u*)(CAT + (size_t)(mb + tt) * 1024 + 512 + lane * 8) = wv;
            }
        }
    }
    __syncthreads();
}

constexpr int KT_P = 72;
constexpr int QS_P = 136;
typedef short v4i16_t __attribute__((ext_vector_type(4)));
constexpr int TP = 136;
__device__ __forceinline__ bf16x8 tr_frag(const LAS bf16* tile, int row0, int col0, int l16) {
    const LAS bf16* p = tile + (row0 + (l16 >> 2)) * TP + col0 + 4 * (l16 & 3);
    const v4i16_t lo = __builtin_amdgcn_ds_read_tr16_b64_v4i16((LAS v4i16_t*)p);
    const v4i16_t hi = __builtin_amdgcn_ds_read_tr16_b64_v4i16((LAS v4i16_t*)(p + 4 * TP));
    return (bf16x8){lo[0], lo[1], lo[2], lo[3], hi[0], hi[1], hi[2], hi[3]};
}
__device__ __forceinline__ void phase_hg_state(Frame& F) {
    LAS bf16* Kl = (LAS bf16*)F.lds;
    LAS bf16* Vl = (LAS bf16*)(F.lds + 64 * TP * 2);
    const bf16* Kt = (const bf16*)(F.ws + WS_K); const bf16* V = (const bf16*)(F.ws + WS_V);
    bf16* U = (bf16*)(F.ws + WS_U); const float* DEC = (const float*)(F.ws + WS_DEC);
    const int tid = F.tid, lane = F.lane, w = F.wave, l16 = lane & 15, lq = lane >> 4;
    const int s0 = tid >> 4, c8 = tid & 15;
    v4u pk[2], pv[2];
    int unit = F.bid;
    if (unit < 2048) {
        const int bh = unit >> 6; const size_t m0 = (size_t)(bh >> 3) * T + (unit & 63) * 64; const int c0 = (bh & 7) * 128;
#pragma unroll
        for (int j = 0; j < 2; ++j) { const size_t o = (m0 + s0 + 32 * j) * D + c0 + 8 * c8; pk[j] = *(const v4u*)(Kt + o); pv[j] = *(const v4u*)(V + o); }
    }
    for (; unit < 2048; unit += F.G) {
        __syncthreads();
#pragma unroll
        for (int j = 0; j < 2; ++j) { *(LAS v4u*)(Kl + (s0 + 32 * j) * TP + 8 * c8) = pk[j]; *(LAS v4u*)(Vl + (s0 + 32 * j) * TP + 8 * c8) = pv[j]; }
        __syncthreads();
        const int nu = unit + F.G;
        if (nu < 2048) {
            const int bh = nu >> 6; const size_t m0 = (size_t)(bh >> 3) * T + (nu & 63) * 64; const int c0 = (bh & 7) * 128;
#pragma unroll
            for (int j = 0; j < 2; ++j) { const size_t o = (m0 + s0 + 32 * j) * D + c0 + 8 * c8; pk[j] = *(const v4u*)(Kt + o); pv[j] = *(const v4u*)(V + o); }
        }
        const f32x4 dc = *(const f32x4*)(DEC + (size_t)unit * 128 + 16 * w + 4 * lq);
        const bf16x8 a0 = tr_frag(Kl, 8 * lq, 16 * w, l16), a1 = tr_frag(Kl, 32 + 8 * lq, 16 * w, l16);
#pragma unroll
        for (int vb = 0; vb < 8; ++vb) {
            const bf16x8 b0 = tr_frag(Vl, 8 * lq, 16 * vb, l16), b1 = tr_frag(Vl, 32 + 8 * lq, 16 * vb, l16);
            f32x4 acc = (f32x4){0.f, 0.f, 0.f, 0.f};
            acc = __builtin_amdgcn_mfma_f32_16x16x32_bf16(a0, b0, acc, 0, 0, 0);
            acc = __builtin_amdgcn_mfma_f32_16x16x32_bf16(a1, b1, acc, 0, 0, 0);
            v2u o; o.x = pk2(acc[0] * dc[0], acc[1] * dc[1]); o.y = pk2(acc[2] * dc[2], acc[3] * dc[3]);
            *(v2u*)(U + ((size_t)unit * 128 + 16 * vb + l16) * 128 + 16 * w + 4 * lq) = o;
        }
    }
    __syncthreads();
}
__device__ __forceinline__ void phase_hg_scan(Frame& F) {
    bf16* U = (bf16*)(F.ws + WS_U); const float* DEC = (const float*)(F.ws + WS_DEC);
    for (int it = F.bid * NTHR + F.tid; it < 32 * 128 * 32; it += F.G * NTHR) {
        const int bh = it >> 12, v = (it >> 5) & 127, k4 = (it & 31) * 4;
        bf16* up = U + ((size_t)(bh * 64) * 128 + v) * 128 + k4;
        const float* dp = DEC + (size_t)(bh * 64) * 128 + k4;
        float S0 = 0.f, S1 = 0.f, S2 = 0.f, S3 = 0.f;
        for (int cb = 0; cb < 64; cb += 8) {
            v2u uu[8]; f32x4 dd[8];
#pragma unroll
            for (int j = 0; j < 8; ++j) { uu[j] = *(const v2u*)(up + (size_t)(cb + j) * 16384); dd[j] = *(const f32x4*)(dp + (cb + j) * 128); }
#pragma unroll
            for (int j = 0; j < 8; ++j) {
                v2u o; o.x = pk2(S0, S1); o.y = pk2(S2, S3);
                *(v2u*)(up + (size_t)(cb + j) * 16384) = o;
                S0 = dd[j][0] * S0 + bflo(uu[j].x); S1 = dd[j][1] * S1 + bfhi(uu[j].x); S2 = dd[j][2] * S2 + bflo(uu[j].y); S3 = dd[j][3] * S3 + bfhi(uu[j].y);
            }
        }
    }
}
__device__ __forceinline__ void phase_hg_out(Frame& F) {
    LAS bf16* Ql = (LAS bf16*)F.lds;
    LAS bf16* Kl = (LAS bf16*)(F.lds + 17408);
    LAS bf16* Vl = (LAS bf16*)(F.lds + 34816);
    LAS bf16* Sc = (LAS bf16*)(F.lds + 52224);
    LAS float* part = (LAS float*)(F.lds + 61440);
    const bf16* Kt = (const bf16*)(F.ws + WS_K); const bf16* V = (const bf16*)(F.ws + WS_V); const bf16* G = (const bf16*)(F.ws + WS_G);
    bf16* Q = (bf16*)(F.ws + WS_Q); const bf16* U = (const bf16*)(F.ws + WS_U); const float* gn = F.in[14];
    const int tid = F.tid, lane = F.lane, w = F.wave, l16 = lane & 15, lq = lane >> 4;
    const int s0 = tid >> 4, c8 = tid & 15;
    v4u pq[2], pk[2], pv[2];
    int unit = F.bid;
    if (unit < 2048) {
        const int bh = unit >> 6; const size_t m0 = (size_t)(bh >> 3) * T + (unit & 63) * 64; const int c0 = (bh & 7) * 128;
#pragma unroll
        for (int j = 0; j < 2; ++j) { const size_t o = (m0 + s0 + 32 * j) * D + c0 + 8 * c8; pq[j] = *(const v4u*)(Q + o); pk[j] = *(const v4u*)(Kt + o); pv[j] = *(const v4u*)(V + o); }
    }
    for (; unit < 2048; unit += F.G) {
        const int bh = unit >> 6; const size_t m0 = (size_t)(bh >> 3) * T + (unit & 63) * 64; const int c0 = (bh & 7) * 128;
        __syncthreads();
#pragma unroll
        for (int j = 0; j < 2; ++j) { const int lo = (s0 + 32 * j) * TP + 8 * c8; *(LAS v4u*)(Ql + lo) = pq[j]; *(LAS v4u*)(Kl + lo) = pk[j]; *(LAS v4u*)(Vl + lo) = pv[j]; }
        __syncthreads();
        bf16x8 st[4];
#pragma unroll
        for (int kk = 0; kk < 4; ++kk) st[kk] = *(const bf16x8*)(U + ((size_t)unit * 128 + 16 * w + l16) * 128 + 8 * lq + 32 * kk);
        v2u gg[4];
#pragma unroll
        for (int tb = 0; tb < 4; ++tb) gg[tb] = *(const v2u*)(G + (m0 + 16 * tb + l16) * D + c0 + 16 * w + 4 * lq);
        {
            const int nu = unit + F.G;
            if (nu < 2048) {
                const int nbh = nu >> 6; const size_t nm0 = (size_t)(nbh >> 3) * T + (nu & 63) * 64; const int nc0 = (nbh & 7) * 128;
#pragma unroll
                for (int j = 0; j < 2; ++j) { const size_t o = (nm0 + s0 + 32 * j) * D + nc0 + 8 * c8; pq[j] = *(const v4u*)(Q + o); pk[j] = *(const v4u*)(Kt + o); pv[j] = *(const v4u*)(V + o); }
            }
        }
        {
            const int tb = w >> 1;
            bf16x8 qf[4];
#pragma unroll
            for (int kk = 0; kk < 4; ++kk) qf[kk] = *(const LAS bf16x8*)(Ql + (16 * tb + l16) * TP + 8 * lq + 32 * kk);
#pragma unroll
            for (int j = 0; j < 2; ++j) {
                const int sb = 2 * (w & 1) + j;
                f32x4 acc = (f32x4){0.f, 0.f, 0.f, 0.f};
                if (sb <= tb) {
#pragma unroll
                    for (int kk = 0; kk < 4; ++kk) { const bf16x8 kf = *(const LAS bf16x8*)(Kl + (16 * sb + l16) * TP + 8 * lq + 32 * kk);
                        acc = __builtin_amdgcn_mfma_f32_16x16x32_bf16(kf, qf[kk], acc, 0, 0, 0); }
                    const int t = 16 * tb + l16, sx = 16 * sb + 4 * lq;
#pragma unroll
                    for (int i = 0; i < 4; ++i) if (sx + i > t) acc[i] = 0.f;
                }
                v2u o; o.x = pk2(acc[0], acc[1]); o.y = pk2(acc[2], acc[3]);
                *(LAS v2u*)(Sc + (16 * tb + l16) * KT_P + 16 * sb + 4 * lq) = o;
            }
        }
        __syncthreads();
        f32x4 oacc[4];
        {
            const bf16x8 vf0 = tr_frag(Vl, 8 * lq, 16 * w, l16), vf1 = tr_frag(Vl, 32 + 8 * lq, 16 * w, l16);
#pragma unroll
            for (int tb = 0; tb < 4; ++tb) {
                f32x4 acc = (f32x4){0.f, 0.f, 0.f, 0.f};
#pragma unroll
                for (int kk = 0; kk < 4; ++kk) { const bf16x8 qf = *(const LAS bf16x8*)(Ql + (16 * tb + l16) * TP + 8 * lq + 32 * kk);
                    acc = __builtin_amdgcn_mfma_f32_16x16x32_bf16(st[kk], qf, acc, 0, 0, 0); }
                const bf16x8 sa = *(const LAS bf16x8*)(Sc + (16 * tb + l16) * KT_P + 8 * lq), sb2 = *(const LAS bf16x8*)(Sc + (16 * tb + l16) * KT_P + 8 * lq + 32);
                acc = __builtin_amdgcn_mfma_f32_16x16x32_bf16(vf0, sa, acc, 0, 0, 0);
                acc = __builtin_amdgcn_mfma_f32_16x16x32_bf16(vf1, sb2, acc, 0, 0, 0);
                oacc[tb] = acc;
                float p = (acc[0] * acc[0] + acc[1] * acc[1]) + (acc[2] * acc[2] + acc[3] * acc[3]);
                p += __shfl_xor(p, 16); p += __shfl_xor(p, 32);
                if (lane < 16) part[w * 64 + 16 * tb + lane] = p;
            }
        }
        __syncthreads();
        {
            const f32x4 gv = *(const f32x4*)(gn + c0 + 16 * w + 4 * lq);
#pragma unroll
            for (int tb = 0; tb < 4; ++tb) {
                const int t = 16 * tb + l16;
                float sm = 0.f;
#pragma unroll
                for (int ww = 0; ww < 8; ++ww) sm += part[ww * 64 + t];
                const float rstd = rsqrtf(sm * (1.0f / 128.0f) + EPS);
                const size_t off = (m0 + t) * D + c0 + 16 * w + 4 * lq;
                v2u o; o.x = pk2(oacc[tb][0] * rstd * gv[0] * bflo(gg[tb].x), oacc[tb][1] * rstd * gv[1] * bfhi(gg[tb].x));
                o.y = pk2(oacc[tb][2] * rstd * gv[2] * bflo(gg[tb].y), oacc[tb][3] * rstd * gv[3] * bfhi(gg[tb].y));
                *(v2u*)(Q + off) = o;
            }
        }
    }
    __syncthreads();
}
__device__ __forceinline__ void phase_final(Frame& F) {
    const float* ss = (const float*)(F.ws + WS_SS) + 4 * SSN; const float* fg = F.in[3];
    const int gw = F.bid * NWAVES + F.wave, NGW = F.G * NWAVES;
    f32x4 g[4];
#pragma unroll
    for (int j = 0; j < 4; ++j) g[j] = *((const f32x4*)fg + F.lane + 64 * j);
    for (int m = gw; m < M; m += NGW) {
        const float rs = row_rstd(ss, m);
        f32x4* xr = (f32x4*)(F.out + (size_t)m * D) + F.lane;
#pragma unroll
        for (int j = 0; j < 4; ++j) { f32x4 v = xr[64 * j]; v = v * rs * g[j]; xr[64 * j] = v; }
    }
}


#define DBG_STOP(k) do { } while (0)
#define GEMM_PHASE(EPI, Aptr, Bptr, NN, KK, E) do { pg8::Gemm g_{(const pg8::bf16_t*)(Aptr), (const pg8::bf16_t*)(Bptr), M, (NN), (KK)}; pg8::StaticOrder S_; S_.init(M, (NN), F.G, F.bid); \
        pg8::gemm_phase<EPI, pg8::StaticOrder, true, true>(F.lds, g_, S_, (E)); } while (0)

__global__ void __launch_bounds__(NTHR, 2) trunk_fwd(Args args) {
    extern __shared__ __attribute__((aligned(16))) unsigned char lds_raw[];
    Frame F;
    F.lds = (LAS unsigned char*)lds_raw;
    F.tid = threadIdx.x; F.lane = F.tid & 63; F.wave = __builtin_amdgcn_readfirstlane(F.tid >> 6);
    F.G = gridDim.x; F.bid = blockIdx.x;
    F.in = args.in; F.out = args.out; F.ws = args.ws;
    unsigned char* ws = args.ws;
    float* ss = (float*)(ws + WS_SS);
    bf16* HB = (bf16*)args.out;
    bf16* HB1 = (bf16*)(ws + WS_HB);

    for (int u = F.tid; u < (LDS_BYTES - LDSCTL_OFF) / 4; u += NTHR) ((LAS unsigned*)(F.lds + LDSCTL_OFF))[u] = 0u;
    __syncthreads();
    XcdBarrier bar = xcd_barrier_post((unsigned*)(ws + WS_CTL), (volatile LAS unsigned*)(F.lds + MISC_OFF) + 8);
    cg::this_grid().sync();
#define GRID_SYNC() xcd_barrier(bar)
#if !defined(PHMASK) || (PHMASK & (1 << 0))
    p0_prologue(F);
#endif
    GRID_SYNC();
    DBG_STOP(0);
#if !defined(PHMASK) || (PHMASK & (1 << 1))
    { EpiInCP E{(bf16*)(ws + WS_AG), (bf16*)(ws + WS_UU), ss}; GEMM_PHASE(EpiInCP, HB, ws + WS_WIN0, NIN0, D, E); }
#endif
    GRID_SYNC();
    DBG_STOP(1);
#if !defined(PHMASK) || (PHMASK & (1 << 2))
    phase_convpool(F);
#endif
    GRID_SYNC();
    DBG_STOP(2);
#if !defined(PHMASK) || (PHMASK & (1 << 4))
    { EpiResid E{HB, HB, nullptr, ss + SSN}; GEMM_PHASE(EpiResid, ws + WS_CAT, ws + WS_WOUT0, D, D, E); }
#endif
    GRID_SYNC();
    DBG_STOP(4);
#if !defined(PHMASK) || (PHMASK & (1 << 5))
    { EpiSwiGLU E{(bf16*)(ws + WS_HID), ss + SSN}; GEMM_PHASE(EpiSwiGLU, HB, ws + WS_UP0, NUP, D, E); }
#endif
    GRID_SYNC();
    DBG_STOP(5);
#if !defined(PHMASK) || (PHMASK & (1 << 6))
    { EpiResid E{HB, HB, nullptr, ss + 2 * SSN}; GEMM_PHASE(EpiResid, ws + WS_HID, ws + WS_DN0, D, FF, E); }
#endif
    GRID_SYNC();
    DBG_STOP(6);
#if !defined(PHMASK) || (PHMASK & (1 << 7))
    { EpiHgIn E{(bf16*)(ws + WS_Q), (bf16*)(ws + WS_K), (bf16*)(ws + WS_V), (bf16*)(ws + WS_G), (float*)(ws + WS_DEC), ss + 2 * SSN, F.in[13]}; GEMM_PHASE(EpiHgIn, HB, ws + WS_HGIN, NHG, D, E); }
#endif
    GRID_SYNC();
    DBG_STOP(7);
#if !defined(PHMASK) || (PHMASK & (1 << 8))
    phase_hg_state(F);
#endif
    GRID_SYNC();
    DBG_STOP(8);
#if !defined(PHMASK) || (PHMASK & (1 << 9))
    phase_hg_scan(F);
#endif
    GRID_SYNC();
    DBG_STOP(9);
#if !defined(PHMASK) || (PHMASK & (1 << 10))
    phase_hg_out(F);
#endif
    GRID_SYNC();
    DBG_STOP(10);
#if !defined(PHMASK) || (PHMASK & (1 << 11))
    { EpiResid E{HB, HB1, nullptr, ss + 3 * SSN}; GEMM_PHASE(EpiResid, ws + WS_Q, ws + WS_HGOUT, D, D, E); }
#endif
    GRID_SYNC();
    DBG_STOP(11);
#if !defined(PHMASK) || (PHMASK & (1 << 12))
    { EpiSwiGLU E{(bf16*)(ws + WS_HID), ss + 3 * SSN}; GEMM_PHASE(EpiSwiGLU, HB1, ws + WS_UP1, NUP, D, E); }
#endif
    GRID_SYNC();
    DBG_STOP(12);
#if !defined(PHMASK) || (PHMASK & (1 << 13))
    { EpiResid E{HB1, nullptr, F.out, ss + 4 * SSN}; GEMM_PHASE(EpiResid, ws + WS_HID, ws + WS_DN1, D, FF, E); }
#endif
    GRID_SYNC();
    DBG_STOP(13);
#if !defined(PHMASK) || (PHMASK & (1 << 14))
    phase_final(F);
#endif
}

extern "C" void kernel_launch(void* const* d_in, const int* in_sizes, int n_in, void* d_out, int out_size, void* d_ws, size_t ws_size, hipStream_t stream) {
    static int grid = 0;
    if (grid == 0) {
        if (n_in != 19 || out_size != M * D || ws_size < WS_END) { fprintf(stderr, "kernel_launch: unexpected shapes (n_in %d out %d ws %zu)\n", n_in, out_size, ws_size); grid = -1; return; }
        int dev = 0, cus = 0, per_cu = 0;
        (void)hipGetDevice(&dev);
        (void)hipDeviceGetAttribute(&cus, hipDeviceAttributeMultiprocessorCount, dev);
        if (hipFuncSetAttribute((const void*)trunk_fwd, hipFuncAttributeMaxDynamicSharedMemorySize, LDS_BYTES) != hipSuccess) { fprintf(stderr, "kernel_launch: hipFuncSetAttribute failed\n"); grid = -1; return; }
        if (hipOccupancyMaxActiveBlocksPerMultiprocessor(&per_cu, (const void*)trunk_fwd, NTHR, LDS_BYTES) != hipSuccess || per_cu < 1) { fprintf(stderr, "kernel_launch: occupancy query says %d\n", per_cu); per_cu = 1; }
        (void)hipGetLastError();
        grid = cus * 1;
        if (grid > cus * per_cu) grid = cus * per_cu;
        fprintf(stderr, "kernel_launch: grid %d (cus %d, per_cu %d)\n", grid, cus, per_cu);
    }
    if (grid < 0) return;
    if (hipMemsetAsync((char*)d_ws + WS_CTL, 0, CTL_ZERO_BYTES, stream) != hipSuccess) { fprintf(stderr, "kernel_launch: memset failed\n"); return; }
    Args a{};
    for (int i = 0; i < 19; ++i) a.in[i] = (const float*)d_in[i];
    a.out = (float*)d_out; a.ws = (unsigned char*)d_ws;
    void* kargs[] = {&a};
    hipError_t e = hipLaunchCooperativeKernel((const void*)trunk_fwd, dim3(grid), dim3(NTHR), kargs, LDS_BYTES, stream);
    if (e != hipSuccess) fprintf(stderr, "kernel_launch: cooperative launch failed: %s (grid %d)\n", hipGetErrorString(e), grid);
}
```
